# Optimizing an MI355X kernel written in HIP

```python
import jax, jax.numpy as jnp
from jax import lax
import numpy as np

D_MODEL = 1024
BATCH = 4
SEQ = 4096
DEPTH = 2
DEC_BATCH = 128
DEC_SEQ = 4
PAST_LEN = 16384
PAGE_SIZE = 128

ATT_HEADS = 8
ATT_KV_HEADS = 2
HEAD_DIM = 64
GROUP = ATT_HEADS // ATT_KV_HEADS
ATT_WIDTH = ATT_HEADS * HEAD_DIM
KV_WIDTH = ATT_KV_HEADS * HEAD_DIM
WINDOW = 128
Q_BLOCK = 128
ROT_DIM = HEAD_DIM // 4
ROPE_THETA = 500000.0
HG_HEADS = 4
HG_DK = 128
HG_DV = 128
HG_KEY_WIDTH = HG_HEADS * HG_DK
HG_VAL_WIDTH = HG_HEADS * HG_DV
HG_CHUNK = 32
MIX_WIDTH = ATT_WIDTH + HG_VAL_WIDTH
IN_WIDTH = ATT_WIDTH + 2 * KV_WIDTH + 2 * HG_KEY_WIDTH + 2 * HG_VAL_WIDTH
D_FF = 4 * D_MODEL
EPS = 1e-6

kernel_name = 'hymba_swa_sink_hgrn2_decoder_step'


def rms_norm(x, g):
    xf = x.astype(jnp.float32)
    y = xf * lax.rsqrt(jnp.mean(xf * xf, axis=-1, keepdims=True) + EPS)
    return (y * g.astype(jnp.float32)).astype(x.dtype)


def partial_rotary(x, pos):
    half = ROT_DIM // 2
    inv_freq = jnp.power(ROPE_THETA, -jnp.arange(half, dtype=jnp.float32) * (2.0 / ROT_DIM))
    ang = pos.astype(jnp.float32)[:, None] * inv_freq[None, :]
    cos = jnp.cos(ang)[None, :, None, :]
    sin = jnp.sin(ang)[None, :, None, :]
    xf = x.astype(jnp.float32)
    x1 = xf[..., :half]
    x2 = xf[..., half:ROT_DIM]
    out = jnp.concatenate([x1 * cos - x2 * sin, x2 * cos + x1 * sin, xf[..., ROT_DIM:]], axis=-1)
    return out.astype(x.dtype)


def window_attention(q, k_full, v_full, n_prefix_valid, sinks):
    B, L = q.shape[0], q.shape[1]
    qb = min(Q_BLOCK, L)
    n_blk = L // qb
    span = qb + WINDOW
    key_idx = jnp.arange(n_blk)[:, None] * qb + jnp.arange(span)[None, :]
    kb = k_full[:, key_idx]
    vb = v_full[:, key_idx]
    qg = q.reshape(B, n_blk, qb, ATT_KV_HEADS, GROUP, HEAD_DIM)
    scores = jnp.einsum('bnqkgd,bnskd->bnkgqs', qg, kb,
                        preferred_element_type=jnp.float32) * (HEAD_DIM ** -0.5)
    q_idx = WINDOW + jnp.arange(n_blk)[:, None] * qb + jnp.arange(qb)[None, :]
    dist = q_idx[:, :, None] - key_idx[:, None, :]
    allowed = (dist >= 0) & (dist <= WINDOW) & (key_idx[:, None, :] >= WINDOW - n_prefix_valid)
    scores = jnp.where(allowed[None, :, None, None, :, :], scores, -jnp.inf)
    sink = sinks.astype(jnp.float32).reshape(ATT_KV_HEADS, GROUP)[None, None, :, :, None, None]
    m = jnp.maximum(jnp.max(scores, axis=-1, keepdims=True), sink)
    p = jnp.exp(scores - m)
    denom = jnp.sum(p, axis=-1, keepdims=True) + jnp.exp(sink - m)
    out = jnp.einsum('bnkgqs,bnskd->bnqkgd', (p / denom).astype(v_full.dtype), vb)
    return out.reshape(B, L, ATT_WIDTH)


def hgrn2_recurrence(q, k, v, log_f, s0):
    B, L = q.shape[0], q.shape[1]
    c = min(HG_CHUNK, L)
    n = -(-L // c)
    pad = n * c - L

    def prep(a):
        a = jnp.pad(a.astype(jnp.float32), ((0, 0), (0, pad), (0, 0), (0, 0)))
        return a.reshape(B, n, c, HG_HEADS, a.shape[-1]).transpose(1, 0, 3, 2, 4)

    qc, kc, vc, gc = prep(q), prep(k), prep(v), prep(log_f)
    causal = jnp.tril(jnp.ones((c, c), dtype=bool))

    def step(S, inp):
        qi, ki, vi, gi = inp
        b = jnp.cumsum(gi, axis=2)
        o_inter = jnp.einsum('bhtd,bhde->bhte', qi * jnp.exp(b), S)
        diff = b[:, :, :, None, :] - b[:, :, None, :, :]
        decay = jnp.exp(jnp.where(causal[None, None, :, :, None], diff, -jnp.inf))
        a = jnp.einsum('bhtd,bhsd,bhtsd->bhts', qi, ki, decay)
        o = o_inter + jnp.einsum('bhts,bhse->bhte', a, vi)
        b_last = b[:, :, -1:, :]
        S_new = jnp.exp(b_last[:, :, 0, :, None]) * S + \
            jnp.einsum('bhsd,bhse->bhde', ki * jnp.exp(b_last - b), vi)
        return S_new, o

    S_fin, o = lax.scan(step, s0.astype(jnp.float32), (qc, kc, vc, gc))
    o = o.transpose(1, 0, 3, 2, 4).reshape(B, n * c, HG_HEADS, HG_DV)[:, :L]
    return o, S_fin


def mixer(h, k_prefix, v_prefix, s0, pos0, n_prefix_valid, w_in_l, sinks_l, lb_l, out_norm_l):
    B, L, _ = h.shape
    proj = jnp.einsum('bld,de->ble', h, w_in_l)
    widths = [ATT_WIDTH, KV_WIDTH, KV_WIDTH, HG_KEY_WIDTH, HG_KEY_WIDTH, HG_VAL_WIDTH]
    splits = []
    acc = 0
    for wd in widths:
        acc += wd
        splits.append(acc)
    q_a, k_a, v_a, q_h, f_h, i_h, g_h = jnp.split(proj, splits, axis=-1)

    pos = pos0 + jnp.arange(L, dtype=jnp.int32)
    q_a = partial_rotary(q_a.reshape(B, L, ATT_HEADS, HEAD_DIM), pos)
    k_a = partial_rotary(k_a.reshape(B, L, ATT_KV_HEADS, HEAD_DIM), pos)
    v_a = v_a.reshape(B, L, ATT_KV_HEADS, HEAD_DIM)
    k_full = jnp.concatenate([k_prefix.astype(k_a.dtype), k_a], axis=1)
    v_full = jnp.concatenate([v_prefix.astype(v_a.dtype), v_a], axis=1)
    att_out = window_attention(q_a, k_full, v_full, n_prefix_valid, sinks_l)
    new_k = k_full[:, -WINDOW:]
    new_v = v_full[:, -WINDOW:]

    z = f_h.astype(jnp.float32).reshape(B, L, HG_HEADS, HG_DK)
    lb = lb_l.reshape(HG_HEADS, HG_DK)
    log_f = jnp.logaddexp(jnp.log(lb), jnp.log1p(-lb) + jax.nn.log_sigmoid(z))
    k_in = (1.0 - lb) * jax.nn.sigmoid(-z)
    q_in = jax.nn.silu(q_h.astype(jnp.float32)).reshape(B, L, HG_HEADS, HG_DK)
    v_in = i_h.reshape(B, L, HG_HEADS, HG_DV)
    o, S_fin = hgrn2_recurrence(q_in, k_in, v_in, log_f, s0)
    gate = jax.nn.silu(g_h.astype(jnp.float32)).reshape(B, L, HG_HEADS, HG_DV)
    hg_out = (rms_norm(o, out_norm_l) * gate).reshape(B, L, HG_VAL_WIDTH)

    mix = jnp.concatenate([att_out.astype(h.dtype), hg_out.astype(h.dtype)], axis=-1)
    return mix, new_k, new_v, S_fin.astype(s0.dtype)


def trunk(x, k_bufs, v_bufs, states, pos0, n_prefix_valid, attn_norm, w_in, att_sinks,
          lower_bounds, hgrn_out_norm, w_o, mlp_norm, w_up, w_down, final_norm):
    new_ks, new_vs, new_ss = [], [], []
    for l in range(DEPTH):
        h = rms_norm(x, attn_norm[l])
        mix, nk, nv, ns = mixer(h, k_bufs[l], v_bufs[l], states[l], pos0, n_prefix_valid,
                                w_in[l], att_sinks[l], lower_bounds[l], hgrn_out_norm[l])
        x = x + jnp.einsum('ble,ed->bld', mix, w_o[l])
        h = rms_norm(x, mlp_norm[l])
        u = jnp.square(jax.nn.relu(jnp.einsum('bld,df->blf', h, w_up[l])))
        x = x + jnp.einsum('blf,fd->bld', u, w_down[l])
        new_ks.append(nk)
        new_vs.append(nv)
        new_ss.append(ns)
    return rms_norm(x, final_norm), jnp.stack(new_ks), jnp.stack(new_vs), jnp.stack(new_ss)


def setup_inputs(seed: int = 0) -> dict:
    key = jax.random.key(seed)
    ks = jax.random.split(key, 16)
    f32 = jnp.float32
    nrm = lambda k, shape: jax.random.normal(k, shape, dtype=f32)
    return {
        'x_prompt': nrm(ks[0], (BATCH, SEQ, D_MODEL)),
        'x_sample': nrm(ks[1], (DEC_BATCH, DEC_SEQ, D_MODEL)),
        'cache_k': nrm(ks[2], (DEPTH, DEC_BATCH, WINDOW, ATT_KV_HEADS, HEAD_DIM)),
        'cache_v': nrm(ks[3], (DEPTH, DEC_BATCH, WINDOW, ATT_KV_HEADS, HEAD_DIM)),
        'state_hgrn': 0.3 * nrm(ks[4], (DEPTH, DEC_BATCH, HG_HEADS, HG_DK, HG_DV)),
        'attn_norm': 1.0 + 0.02 * nrm(ks[5], (DEPTH, D_MODEL)),
        'w_in': nrm(ks[6], (DEPTH, D_MODEL, IN_WIDTH)) * D_MODEL ** -0.5,
        'att_sinks': 0.5 * nrm(ks[7], (DEPTH, ATT_HEADS)),
        'hgrn_lower_bounds': 0.1 * nrm(ks[8], (DEPTH, HG_KEY_WIDTH)),
        'hgrn_out_norm': 1.0 + 0.02 * nrm(ks[9], (DEPTH, HG_DV)),
        'w_o': nrm(ks[10], (DEPTH, MIX_WIDTH, D_MODEL)) * MIX_WIDTH ** -0.5,
        'mlp_norm': 1.0 + 0.02 * nrm(ks[11], (DEPTH, D_MODEL)),
        'w_up': nrm(ks[12], (DEPTH, D_MODEL, D_FF)) * D_MODEL ** -0.5,
        'w_down': nrm(ks[13], (DEPTH, D_FF, D_MODEL)) * D_FF ** -0.5,
        'final_norm': 1.0 + 0.02 * nrm(ks[14], (D_MODEL,)),
    }


def reference(x_prompt, x_sample, cache_k, cache_v, state_hgrn, attn_norm, w_in, att_sinks,
              hgrn_lower_bounds, hgrn_out_norm, w_o, mlp_norm, w_up, w_down, final_norm):
    p = jax.nn.softmax(hgrn_lower_bounds.astype(jnp.float32), axis=0)
    lower_bounds = jnp.maximum(jnp.cumsum(p, axis=0) - p[0:1], 0.0)
    weights = (attn_norm, w_in, att_sinks, lower_bounds, hgrn_out_norm, w_o, mlp_norm, w_up, w_down, final_norm)

    zero_kv = jnp.zeros((DEPTH, BATCH, WINDOW, ATT_KV_HEADS, HEAD_DIM), dtype=x_prompt.dtype)
    zero_s = jnp.zeros((DEPTH, BATCH, HG_HEADS, HG_DK, HG_DV), dtype=state_hgrn.dtype)
    y_prompt, nk_p, nv_p, ns_p = trunk(x_prompt, zero_kv, zero_kv, zero_s, 0, 0, *weights)

    y_sample, nk_s, nv_s, ns_s = trunk(x_sample, cache_k, cache_v, state_hgrn, PAST_LEN,
                                       min(WINDOW, PAST_LEN), *weights)
    return (y_prompt, y_sample, nk_p, nv_p, ns_p, nk_s, nv_s, ns_s)
```

```cpp
#include <hip/hip_runtime.h>
#include <cstdio>
#include <cstdint>
#include <cmath>

namespace pg8 {
#define PG8_LAS __attribute__((address_space(3)))
typedef unsigned short bf16_t;
typedef short bf16x8 __attribute__((ext_vector_type(8)));
typedef float f32x4 __attribute__((ext_vector_type(4)));
typedef unsigned u32x4 __attribute__((ext_vector_type(4)));
typedef unsigned u32x2 __attribute__((ext_vector_type(2)));
constexpr int BM = 256, BK = 64, HALF = 128, HTB = HALF * BK * 2, STAGE_BYTES = 8 * HTB, NXCD = 8, WGM = 4;

__host__ __device__ __forceinline__ int lds_byte(int r, int c) { const int st = (r >> 4) * 2 + (c >> 5), rr = r & 15, cc = c & 31, ob = rr * 64 + cc * 2; return st * 1024 + (ob ^ (((ob >> 9) & 1) << 5)); }
__host__ __device__ __forceinline__ void stage_rc(int b, int& R, int& C) { const int st = b / 1024, sb = b % 1024, swz = sb ^ (((sb >> 9) & 1) << 5); R = (st >> 1) * 16 + swz / 64; C = (st & 1) * 32 + (swz % 64) / 2; }
__host__ __device__ __forceinline__ int perm32(int rho) { const int n = rho >> 4, i = rho & 15; return 8 * (i >> 2) + 4 * n + (i & 3); }

struct Unit { int pm, pn; };
struct Gemm { const bf16_t* A; const bf16_t* Bt; int M, N, K; };

struct StaticOrder {
    int nM, nN, nwg, G, c, nMm, nwgm;
    __host__ __device__ void init(int M, int N, int G_, int c_) { nM = M / BM; nN = N / BM; nwg = nM * nN; G = G_; c = c_; nMm = nM & ~7; nwgm = nMm * nN; }
    __host__ __device__ bool next(int i, Unit& u) const {
        const long L = (long)i * G + c; if (L >= nwg) return false;
        if (L >= nwgm) { const int s = (int)L - nwgm; u.pm = nMm + s / nN; u.pn = s % nN; return true; }
        int wgid = (int)L; { const int q = nwgm / NXCD, r = nwgm % NXCD, xcd = wgid % NXCD, off = wgid / NXCD; wgid = (xcd < r ? xcd * (q + 1) : r * (q + 1) + (xcd - r) * q) + off; }
        const int nig = WGM * nN, gid = wgid / nig, fm = gid * WGM, gsz = (nMm - fm) < WGM ? (nMm - fm) : WGM;
        u.pm = fm + ((wgid % nig) % gsz); u.pn = (wgid % nig) / gsz; return true;
    }
    __device__ __forceinline__ void a_ready(const Unit&) const {}
    __device__ __forceinline__ void done(const Unit&) const {}
};

__device__ __forceinline__ unsigned cvt_pk_bf16(float lo, float hi) { unsigned r; asm volatile("v_cvt_pk_bf16_f32 %0, %1, %2" : "=v"(r) : "v"(lo), "v"(hi)); return r; }

constexpr int NTOK_P = 16384, PW = 2816;
constexpr float RMS_EPS = 1e-6f;
constexpr float QSCALE = 0.125f * 1.4426950408889634f;

__device__ __forceinline__ void row_rstd8(const float* ssq, int row0, int fq, float (&rs)[8]) {
    f32x4 p[8];
#pragma unroll
    for (int i = 0; i < 8; ++i) p[i] = *(const f32x4*)(ssq + (size_t)(row0 + (i >> 2) * HALF + (i & 3) * 16) * 16 + 4 * fq);
#pragma unroll
    for (int i = 0; i < 8; ++i) { float s = (p[i][0] + p[i][1]) + (p[i][2] + p[i][3]); s += __shfl_xor(s, 16); s += __shfl_xor(s, 32); rs[i] = __builtin_amdgcn_rsqf(s * (1.0f / 1024.0f) + RMS_EPS); }
}

struct EpiIn {
    static constexpr bool PERM = true, AFTER_DRAIN = false;
    __device__ __forceinline__ bool perm() const { return true; }
    bf16_t* P; const float* ssq; const float* rot; const float* lb;
    float* nk_p; float* nv_p; float* nk_s; float* nv_s;
    __device__ __forceinline__ void row_part(const f32x4& a00, const f32x4& a01, const f32x4& a10, const f32x4& a11, int row, int pn, int type, bool rotw, int colw, int fq, const float r) const {
        f32x4 cs[4];
        if (rotw) { const int pidx = row < NTOK_P ? (row & 4095) : 4096 + ((row - NTOK_P) & 3);
#pragma unroll
            for (int i = 0; i < 4; ++i) cs[i] = *(const f32x4*)(rot + (size_t)pidx * 16 + 4 * i); }
#pragma unroll
        for (int bj = 0; bj < 2; ++bj) {
            float v[8];
#pragma unroll
            for (int e = 0; e < 4; ++e) { v[e] = (bj == 0 ? a00[e] : a10[e]) * r; v[4 + e] = (bj == 0 ? a01[e] : a11[e]) * r; }
            const int col = pn * BM + bj * HALF + colw;
            if (type == 0 || (type == 1 && bj == 0)) {
                if (rotw) {
#pragma unroll
                    for (int e = 0; e < 8; ++e) { const float pr = __shfl_xor(v[e], 16); const float c = cs[e >> 1][(e & 1) * 2], s = cs[e >> 1][(e & 1) * 2 + 1];
                        const float rr = (fq == 0) ? (v[e] * c - pr * s) : (v[e] * c + pr * s); v[e] = (fq < 2) ? rr : v[e]; }
                }
                if (type == 0) {
#pragma unroll
                    for (int e = 0; e < 8; ++e) v[e] *= QSCALE;
                }
            } else if (type == 2) {
#pragma unroll
                for (int e = 0; e < 8; ++e) v[e] = v[e] * __builtin_amdgcn_rcpf(1.0f + __builtin_amdgcn_exp2f(-1.4426950408889634f * v[e]));
            } else if (type == 3) {
                const f32x4 l0 = *(const f32x4*)(lb + (col - 1280)), l1 = *(const f32x4*)(lb + (col - 1280) + 4);
#pragma unroll
                for (int e = 0; e < 8; ++e) { const float lbv = e < 4 ? l0[e & 3] : l1[e & 3]; const float z = fmaxf(v[e], -80.f);
                    const float sg = __builtin_amdgcn_rcpf(1.0f + __builtin_amdgcn_exp2f(-1.4426950408889634f * z));
                    v[e] = __builtin_amdgcn_logf(lbv + (1.0f - lbv) * sg); }
            }
            u32x4 w; w.x = cvt_pk_bf16(v[0], v[1]); w.y = cvt_pk_bf16(v[2], v[3]); w.z = cvt_pk_bf16(v[4], v[5]); w.w = cvt_pk_bf16(v[6], v[7]);
            *(u32x4*)(P + (size_t)row * PW + col) = w;
            if (type == 1) {
                bool inc; float* dst;
                if (row < NTOK_P) { const int t = row & 4095, b = row >> 12; inc = t >= 3968; dst = (bj == 0 ? nk_p : nv_p) + ((size_t)(b * 128 + (t - 3968)) * 128 + colw); }
                else { const int r2 = row - NTOK_P, sb = r2 >> 2, i = r2 & 3; inc = true; dst = (bj == 0 ? nk_s : nv_s) + ((size_t)(sb * 128 + 124 + i) * 128 + colw); }
                if (inc) { *(f32x4*)dst = (f32x4){v[0], v[1], v[2], v[3]}; *(f32x4*)(dst + 4) = (f32x4){v[4], v[5], v[6], v[7]}; }
            }
        }
        asm volatile("" ::: "memory");
    }
    __device__ __forceinline__ void operator()(const f32x4 (&acc)[2][2][4][2], const Unit& u, int wr, int wc, int fr, int fq) const {
        const int pn = u.pn, row0 = u.pm * BM + wr * 64 + fr, colw = wc * 32 + 8 * fq;
        int type;
        if (pn < 2) type = 0; else if (pn == 2) type = 1; else if (pn < 5) type = 2; else if (pn < 7) type = 3; else if (pn < 9) type = 4; else type = 2;
        const bool rotw = ((wc & 1) == 0) && (type <= 1);
        float rs[8]; row_rstd8(ssq, row0, fq, rs);
#define EPIIN_ROW(ai, m) row_part(acc[ai][0][m][0], acc[ai][0][m][1], acc[ai][1][m][0], acc[ai][1][m][1], row0 + (ai) * HALF + (m) * 16, pn, type, rotw, colw, fq, rs[(ai) * 4 + (m)])
        EPIIN_ROW(0, 0); EPIIN_ROW(0, 1); EPIIN_ROW(0, 2); EPIIN_ROW(0, 3); EPIIN_ROW(1, 0); EPIIN_ROW(1, 1); EPIIN_ROW(1, 2); EPIIN_ROW(1, 3);
#undef EPIIN_ROW
    }
};
struct EpiUp {
    static constexpr bool PERM = true, AFTER_DRAIN = false;
    __device__ __forceinline__ bool perm() const { return true; }
    bf16_t* O; int ldc; const float* ssq;
    __device__ __forceinline__ void operator()(const f32x4 (&acc)[2][2][4][2], const Unit& u, int wr, int wc, int fr, int fq) const {
        const int row0 = u.pm * BM + wr * 64 + fr, col0 = u.pn * BM + wc * 32 + 8 * fq;
        float rs[8]; row_rstd8(ssq, row0, fq, rs);
#pragma unroll
        for (int ai = 0; ai < 2; ++ai)
#pragma unroll
            for (int m = 0; m < 4; ++m) { bf16_t* rowp = O + (size_t)(row0 + ai * HALF + m * 16) * ldc + col0; const float r = rs[ai * 4 + m];
#pragma unroll
                for (int bj = 0; bj < 2; ++bj) { f32x4 v0 = acc[ai][bj][m][0] * r, v1 = acc[ai][bj][m][1] * r;
#pragma unroll
                    for (int e = 0; e < 4; ++e) { const float a = fmaxf(v0[e], 0.f), b = fmaxf(v1[e], 0.f); v0[e] = a * a; v1[e] = b * b; }
                    u32x4 w; w.x = cvt_pk_bf16(v0[0], v0[1]); w.y = cvt_pk_bf16(v0[2], v0[3]); w.z = cvt_pk_bf16(v1[0], v1[1]); w.w = cvt_pk_bf16(v1[2], v1[3]);
                    *(u32x4*)(rowp + bj * HALF) = w; } }
    }
};
struct EpiRes {
    static constexpr bool PERM = true, AFTER_DRAIN = false;
    __device__ __forceinline__ bool perm() const { return true; }
    bf16_t* xb; float* ssq;
    __device__ __forceinline__ void init(f32x4 (&acc)[2][2][4][2], const Unit& u, int wr, int wc, int fr, int fq) const {
        const int row0 = u.pm * BM + wr * 64 + fr, col0 = u.pn * BM + wc * 32 + 8 * fq;
#pragma unroll
        for (int ai = 0; ai < 2; ++ai)
#pragma unroll
            for (int m = 0; m < 4; ++m)
#pragma unroll
                for (int bj = 0; bj < 2; ++bj) { const u32x4 w = *(const u32x4*)(xb + (size_t)(row0 + ai * HALF + m * 16) * 1024 + col0 + bj * HALF);
                    acc[ai][bj][m][0] = (f32x4){__builtin_bit_cast(float, w.x << 16), __builtin_bit_cast(float, w.x & 0xffff0000u), __builtin_bit_cast(float, w.y << 16), __builtin_bit_cast(float, w.y & 0xffff0000u)};
                    acc[ai][bj][m][1] = (f32x4){__builtin_bit_cast(float, w.z << 16), __builtin_bit_cast(float, w.z & 0xffff0000u), __builtin_bit_cast(float, w.w << 16), __builtin_bit_cast(float, w.w & 0xffff0000u)}; }
    }
    __device__ __forceinline__ void operator()(const f32x4 (&acc)[2][2][4][2], const Unit& u, int wr, int wc, int fr, int fq) const {
        const int row0 = u.pm * BM + wr * 64 + fr, col0 = u.pn * BM + wc * 32 + 8 * fq;
#pragma unroll
        for (int ai = 0; ai < 2; ++ai)
#pragma unroll
            for (int m = 0; m < 4; ++m) {
                const int row = row0 + ai * HALF + m * 16; float ss = 0.f;
#pragma unroll
                for (int bj = 0; bj < 2; ++bj) {
                    const f32x4 x0 = acc[ai][bj][m][0], x1 = acc[ai][bj][m][1];
                    ss += ((x0[0] * x0[0] + x0[1] * x0[1]) + (x0[2] * x0[2] + x0[3] * x0[3])) + ((x1[0] * x1[0] + x1[1] * x1[1]) + (x1[2] * x1[2] + x1[3] * x1[3]));
                    u32x4 w; w.x = cvt_pk_bf16(x0[0], x0[1]); w.y = cvt_pk_bf16(x0[2], x0[3]); w.z = cvt_pk_bf16(x1[0], x1[1]); w.w = cvt_pk_bf16(x1[2], x1[3]);
                    *(u32x4*)(xb + (size_t)row * 1024 + col0 + bj * HALF) = w;
                }
                ss += __shfl_xor(ss, 16); ss += __shfl_xor(ss, 32);
                if (fq == 0) ssq[(size_t)row * 16 + u.pn * 4 + wc] = ss;
            }
    }
};
struct EpiAny {
    static constexpr bool AFTER_DRAIN = false;
    int kind, l;
    unsigned char* ws; float* out; const float* x_p; const float* x_s;
    size_t o_rot, o_lb, o_ssq, ssq_stride, o_proj, o_xb, o_u;
    size_t f_nkp, f_nvp, f_nks, f_nvs;
    __device__ __forceinline__ bool perm() const { return true; }
    __device__ __forceinline__ void init(f32x4 (&acc)[2][2][4][2], const Unit& u, int wr, int wc, int fr, int fq) const {
        if (kind >= 2) { EpiRes E{(bf16_t*)(ws + o_xb), nullptr}; E.init(acc, u, wr, wc, fr, fq); }
        else {
#pragma unroll
            for (int a = 0; a < 2; ++a)
#pragma unroll
                for (int b = 0; b < 2; ++b)
#pragma unroll
                    for (int m = 0; m < 4; ++m)
#pragma unroll
                        for (int n = 0; n < 2; ++n) acc[a][b][m][n] = (f32x4){0.f, 0.f, 0.f, 0.f};
        }
    }
    __device__ __forceinline__ void operator()(const f32x4 (&acc)[2][2][4][2], const Unit& u, int wr, int wc, int fr, int fq) const {
        if (kind == 0) { EpiIn E{(bf16_t*)(ws + o_proj), (const float*)(ws + o_ssq + (size_t)(2 * l) * ssq_stride), (const float*)(ws + o_rot), (const float*)(ws + o_lb) + l * 512,
                                 out + f_nkp + (size_t)l * 65536, out + f_nvp + (size_t)l * 65536, out + f_nks + (size_t)l * 2097152, out + f_nvs + (size_t)l * 2097152}; E(acc, u, wr, wc, fr, fq); }
        else if (kind == 1) { EpiUp E{(bf16_t*)(ws + o_u), 4096, (const float*)(ws + o_ssq + (size_t)(2 * l + 1) * ssq_stride)}; E(acc, u, wr, wc, fr, fq); }
        else { EpiRes E{(bf16_t*)(ws + o_xb), (float*)(ws + o_ssq + (size_t)(2 * l + (kind == 2 ? 1 : 2)) * ssq_stride)}; E(acc, u, wr, wc, fr, fq); }
    }
};

template <class Epi, class Sched, bool ALIGN_EPI = false, bool SP2 = false>
__device__ __forceinline__ void gemm_phase(PG8_LAS unsigned char* lds, const Gemm g, const Sched& S, const Epi& E, const int tid) {
    const int wid = __builtin_amdgcn_readfirstlane(tid >> 6), lane = tid & 63, wr = wid >> 2, wc = wid & 3, fr = lane & 15, fq = lane >> 4;
    const int K = g.K, nt = K / BK;
    unsigned voffA[2], voffB[2];
#pragma unroll
    for (int i = 0; i < 2; ++i) { int R, C; stage_rc(tid * 16 + i * 8192, R, C); const int Rb = E.perm() ? ((R & ~31) + perm32(R & 31)) : R;
        voffA[i] = (unsigned)(R * K + C) * 2u; voffB[i] = (unsigned)(Rb * K + C) * 2u; }
    const size_t kstep = (size_t)(BK * 2);
    const size_t hstep = (size_t)HALF * K * 2;
    const size_t tstep = 2 * hstep;
    const unsigned ldsw = (unsigned)wid * 1024u;
    const int aoff = lds_byte(wr * 64 + fr, fq * 8), boff = lds_byte(wc * 32 + fr, fq * 8);
#define PG8_SA(b, h) (((b) * 2 + (h)) * HTB)
#define PG8_SB(b, h) ((4 + (b) * 2 + (h)) * HTB)
#define PG8_STAGE(bufoff, gbase, voff) do { _Pragma("unroll") for (int _i = 0; _i < 2; ++_i) \
        __builtin_amdgcn_global_load_lds((const unsigned*)((const char*)(gbase) + (voff)[_i]), (PG8_LAS unsigned*)(lds + (bufoff) + ldsw + _i * 8192), 16, 0, 0); } while (0)
#define PG8_LDA(dst, b, h) do { _Pragma("unroll") for (int m = 0; m < 4; ++m) _Pragma("unroll") for (int k = 0; k < 2; ++k) dst[m][k] = *(const PG8_LAS bf16x8*)(lds + PG8_SA(b, h) + aoff + m * 2048 + k * 1024); } while (0)
#define PG8_LDB(dst, b, h) do { _Pragma("unroll") for (int n = 0; n < 2; ++n) _Pragma("unroll") for (int k = 0; k < 2; ++k) dst[n][k] = *(const PG8_LAS bf16x8*)(lds + PG8_SB(b, h) + boff + n * 2048 + k * 1024); } while (0)
#define PG8_MMA(ai, bj, At, Bt) do { __builtin_amdgcn_s_setprio(1); _Pragma("unroll") for (int m = 0; m < 4; ++m) _Pragma("unroll") for (int n = 0; n < 2; ++n) _Pragma("unroll") for (int k = 0; k < 2; ++k) \
        acc[ai][bj][m][n] = __builtin_amdgcn_mfma_f32_16x16x32_bf16(Bt[n][k], At[m][k], acc[ai][bj][m][n], 0, 0, 0); __builtin_amdgcn_s_setprio(0); } while (0)
#define PG8_WAIT_V(n) asm volatile("s_waitcnt vmcnt(" #n ")" ::: "memory")
#define PG8_WAIT_L(n) asm volatile("s_waitcnt lgkmcnt(" #n ")" ::: "memory")
#define PG8_BAR __builtin_amdgcn_s_barrier()
#define PG8_SCHED __builtin_amdgcn_sched_barrier(0)
    Unit cur, nxt; int ui = 0;
    if (!S.next(0, cur)) return;
    f32x4 acc[2][2][4][2];
    bf16x8 At[4][2], B0[2][2], B1[2][2];
    const char* cA = (const char*)g.A + (size_t)cur.pm * tstep; const char* cB = (const char*)g.Bt + (size_t)cur.pn * tstep;
    S.a_ready(cur);
    if constexpr (SP2) {
        PG8_STAGE(PG8_SB(0, 0), cB, voffB); PG8_STAGE(PG8_SB(0, 1), cB + hstep, voffB); PG8_STAGE(PG8_SA(0, 0), cA, voffA); PG8_STAGE(PG8_SA(0, 1), cA + hstep, voffA);
        if (wr == 1) PG8_BAR;
        PG8_WAIT_V(2); PG8_BAR;
        PG8_STAGE(PG8_SB(1, 0), cB + kstep, voffB); PG8_STAGE(PG8_SA(1, 0), cA + kstep, voffA); PG8_STAGE(PG8_SB(1, 1), cB + hstep + kstep, voffB);
        PG8_WAIT_V(6); PG8_BAR;
    } else {
        PG8_STAGE(PG8_SB(0, 0), cB, voffB); PG8_STAGE(PG8_SA(0, 0), cA, voffA); PG8_STAGE(PG8_SB(0, 1), cB + hstep, voffB); PG8_STAGE(PG8_SA(0, 1), cA + hstep, voffA);
        if (wr == 1) PG8_BAR;
        PG8_WAIT_V(4); PG8_BAR;
        PG8_STAGE(PG8_SB(1, 0), cB + kstep, voffB); PG8_STAGE(PG8_SA(1, 0), cA + kstep, voffA); PG8_STAGE(PG8_SB(1, 1), cB + hstep + kstep, voffB);
        PG8_WAIT_V(6); PG8_BAR;
    }
    E.init(acc, cur, wr, wc, fr, fq);
#pragma unroll
    for (int a = 0; a < 2; ++a)
#pragma unroll
        for (int b = 0; b < 2; ++b)
#pragma unroll
            for (int m = 0; m < 4; ++m) asm volatile("" : "+v"(acc[a][b][m][0]), "+v"(acc[a][b][m][1]));
    for (;;) {
        const bool has_next = S.next(ui + 1, nxt);
        const char* nA = has_next ? (const char*)g.A + (size_t)nxt.pm * tstep : cA; const char* nB = has_next ? (const char*)g.Bt + (size_t)nxt.pn * tstep : cB;
        for (int t = 0; t < nt; t += 2) {
            const bool last = (t == nt - 2);
            const char* a1 = cA + (size_t)(t + 1) * kstep;
            const char* a2 = last ? nA : cA + (size_t)(t + 2) * kstep; const char* b2 = last ? nB : cB + (size_t)(t + 2) * kstep;
            const char* a3 = a2 + kstep; const char* b3 = b2 + kstep;
            if (last && has_next) S.a_ready(nxt);
            if constexpr (SP2) {
            PG8_LDB(B0, 0, 0); PG8_LDB(B1, 0, 1); PG8_SCHED; PG8_LDA(At, 0, 0); PG8_STAGE(PG8_SA(1, 1), a1 + hstep, voffA);
            PG8_WAIT_V(8); PG8_WAIT_L(0); PG8_BAR; PG8_MMA(0, 0, At, B0); PG8_MMA(0, 1, At, B1); PG8_BAR; PG8_SCHED;
            PG8_LDA(At, 0, 1); PG8_STAGE(PG8_SB(0, 0), b2, voffB); PG8_STAGE(PG8_SB(0, 1), b2 + hstep, voffB); PG8_STAGE(PG8_SA(0, 0), a2, voffA);
            PG8_WAIT_V(8); PG8_WAIT_L(0); PG8_BAR; PG8_MMA(1, 0, At, B0); PG8_MMA(1, 1, At, B1); PG8_BAR; PG8_SCHED;
            PG8_LDB(B0, 1, 0); PG8_LDB(B1, 1, 1); PG8_SCHED; PG8_LDA(At, 1, 0); PG8_STAGE(PG8_SA(0, 1), a2 + hstep, voffA);
            PG8_WAIT_V(8); PG8_WAIT_L(0); PG8_BAR; PG8_MMA(0, 0, At, B0); PG8_MMA(0, 1, At, B1); PG8_BAR; PG8_SCHED;
            PG8_LDA(At, 1, 1); PG8_STAGE(PG8_SB(1, 0), b3, voffB); PG8_STAGE(PG8_SB(1, 1), b3 + hstep, voffB); PG8_STAGE(PG8_SA(1, 0), a3, voffA);
            PG8_WAIT_V(8); PG8_WAIT_L(0); PG8_BAR; PG8_MMA(1, 0, At, B0); PG8_MMA(1, 1, At, B1); PG8_BAR; PG8_SCHED;
            } else {
            PG8_LDB(B0, 0, 0); PG8_SCHED; PG8_LDA(At, 0, 0); PG8_STAGE(PG8_SA(1, 1), a1 + hstep, voffA);
            PG8_WAIT_L(8); PG8_BAR; PG8_WAIT_L(0); PG8_MMA(0, 0, At, B0); PG8_BAR; PG8_SCHED;
            PG8_LDB(B1, 0, 1); PG8_STAGE(PG8_SB(0, 0), b2, voffB);
            PG8_BAR; PG8_WAIT_L(0); PG8_MMA(0, 1, At, B1); PG8_BAR;
            PG8_LDA(At, 0, 1); PG8_STAGE(PG8_SA(0, 0), a2, voffA);
            PG8_BAR; PG8_WAIT_L(0); PG8_MMA(1, 0, At, B0); PG8_BAR; PG8_SCHED;
            PG8_STAGE(PG8_SB(0, 1), b2 + hstep, voffB);
            PG8_WAIT_V(6); PG8_BAR; PG8_MMA(1, 1, At, B1); PG8_BAR;
            PG8_LDB(B0, 1, 0); PG8_SCHED; PG8_LDA(At, 1, 0); PG8_STAGE(PG8_SA(0, 1), a2 + hstep, voffA);
            PG8_WAIT_L(8); PG8_BAR; PG8_WAIT_L(0); PG8_MMA(0, 0, At, B0); PG8_BAR; PG8_SCHED;
            PG8_LDB(B1, 1, 1); PG8_STAGE(PG8_SB(1, 0), b3, voffB);
            PG8_BAR; PG8_WAIT_L(0); PG8_MMA(0, 1, At, B1); PG8_BAR;
            PG8_LDA(At, 1, 1); PG8_STAGE(PG8_SA(1, 0), a3, voffA);
            PG8_BAR; PG8_WAIT_L(0); PG8_MMA(1, 0, At, B0); PG8_BAR; PG8_SCHED;
            PG8_STAGE(PG8_SB(1, 1), b3 + hstep, voffB);
            PG8_WAIT_V(6); PG8_BAR; PG8_MMA(1, 1, At, B1); PG8_BAR;
            }
        }
        if constexpr (ALIGN_EPI) { if (wr == 0) PG8_BAR; }
        if constexpr (!Epi::AFTER_DRAIN) { E(acc, cur, wr, wc, fr, fq); S.done(cur); }
        if (!has_next) break;
        E.init(acc, nxt, wr, wc, fr, fq);
        cur = nxt; cA = nA; cB = nB; ++ui;
        if constexpr (ALIGN_EPI) { if (wr == 1) PG8_BAR; }
    }
    PG8_WAIT_V(0);
    if constexpr (!ALIGN_EPI) { if (wr == 0) PG8_BAR; }
    PG8_BAR;
#undef PG8_SA
#undef PG8_SB
#undef PG8_STAGE
#undef PG8_LDA
#undef PG8_LDB
#undef PG8_MMA
#undef PG8_WAIT_V
#undef PG8_WAIT_L
#undef PG8_BAR
#undef PG8_SCHED
}
}

constexpr int NWAVES = 8;
#ifndef REP_PRO
#define REP_PRO 1
#endif
#ifndef REP_ATT
#define REP_ATT 1
#endif
#ifndef REP_P1
#define REP_P1 1
#endif
#ifndef REP_P2
#define REP_P2 1
#endif
#ifndef REP_SMP
#define REP_SMP 1
#endif
#ifndef REP_GIN
#define REP_GIN 1
#endif
#ifndef REP_GUP
#define REP_GUP 1
#endif
#ifndef REP_SG
#define REP_SG 1
#endif
constexpr int D = 1024, SEQ = 4096, NB = 4, NTP = NB * SEQ, DB = 128, DS = 4, NTS = DB * DS, M = NTP + NTS;
constexpr int DEPTH = 2, PASTLEN = 16384, WIN = 128;
constexpr int INW = 2816, FF = 4096;
constexpr int C_QA = 0, C_KA = 512, C_VA = 640, C_QH = 768, C_FH = 1280, C_IH = 1792, C_GH = 2304;
constexpr float EPS = 1e-6f;
constexpr float LOG2E = 1.4426950408889634f;
constexpr int NPOS = 4100;
constexpr size_t OFF_Y = 0, OFF_NKP = (size_t)M * D, OFF_NVP = OFF_NKP + 131072, OFF_NSP = OFF_NVP + 131072, OFF_NKS = OFF_NSP + 524288,
                 OFF_NVS = OFF_NKS + 4194304, OFF_NSS = OFF_NVS + 4194304, OUT_TOTAL = OFF_NSS + 16777216;
constexpr size_t MiB = 1u << 20;
constexpr size_t WS_CTL = 0, CTL_ZERO_BYTES = 64 * 1024;
constexpr size_t WS_ROT = 1 * MiB;
constexpr size_t WS_LB = 1 * MiB + 512 * 1024;
constexpr size_t WS_SSQ = 2 * MiB, SSQ_STRIDE = 1310720;
constexpr size_t WS_WIN = 10 * MiB, WS_WO = 21 * MiB, WS_WUP = 25 * MiB, WS_WDN = 41 * MiB;
constexpr size_t WS_XB = 57 * MiB;
constexpr size_t WS_HG = 90 * MiB;
constexpr size_t WS_BIG = 107 * MiB;
constexpr size_t WS_PROJ = WS_BIG, WS_MIX = 198 * MiB, WS_U = WS_BIG, WS_MIXS = 239 * MiB, WS_END = 240 * MiB;
static_assert(WS_SSQ + 5 * SSQ_STRIDE <= WS_WIN && WS_PROJ + (size_t)M * INW * 2 <= WS_MIX && WS_MIX + (size_t)M * D * 2 <= WS_MIXS && WS_U + (size_t)M * FF * 2 <= WS_MIXS && WS_MIXS + (size_t)NTS * D * 2 <= WS_END, "ws map");
static_assert(WS_WIN + (size_t)DEPTH * INW * D * 2 <= WS_WO && WS_XB + (size_t)M * D * 2 <= WS_HG, "ws map 2");

constexpr int RING_OFF = 0, RING_BYTES = 131072, LDSCTL_OFF = RING_BYTES, MISC_OFF = LDSCTL_OFF + 320, LDS_BYTES = 147456;

#define GAS __attribute__((address_space(1)))
#define LAS __attribute__((address_space(3)))
typedef unsigned short bf16;
typedef unsigned v4u __attribute__((ext_vector_type(4)));
typedef float f32x4 __attribute__((ext_vector_type(4)));
typedef GAS unsigned gu32;
#define RLX_AGENT __ATOMIC_RELAXED, __HIP_MEMORY_SCOPE_AGENT
#define LDS_WAIT() asm volatile("s_waitcnt lgkmcnt(0)" ::: "memory")
#define WG_BAR() do { asm volatile("s_waitcnt lgkmcnt(0)" ::: "memory"); __builtin_amdgcn_s_barrier(); asm volatile("" ::: "memory"); } while (0)
__device__ __forceinline__ unsigned f2bf(float f) { unsigned u = __builtin_bit_cast(unsigned, f); return (u + 0x7fffu + ((u >> 16) & 1u)) >> 16; }
__device__ __forceinline__ unsigned pk2(float lo, float hi) { return f2bf(lo) | (f2bf(hi) << 16); }
__device__ __forceinline__ unsigned pkb(float lo, float hi) { return pg8::cvt_pk_bf16(lo, hi); }
__device__ __forceinline__ unsigned pkb1(float v) { return pg8::cvt_pk_bf16(v, v); }
__device__ __forceinline__ float bf2f(bf16 v) { return __builtin_bit_cast(float, (unsigned)v << 16); }
__device__ __forceinline__ float wave_sum(float v) {
#pragma unroll
    for (int o = 1; o < 64; o <<= 1) v += __shfl_xor(v, o);
    return v;
}
__device__ __forceinline__ float wave_max(float v) {
#pragma unroll
    for (int o = 1; o < 64; o <<= 1) v = fmaxf(v, __shfl_xor(v, o));
    return v;
}

#define XB_TMO      128
#define XB_XCNT(j)  (256  + 64 * (j))
#define XB_XSUB(j)  (1280 + 64 * (j))
#define XB_XGEN(j)  (2304 + 64 * (j))
#define XB_TOP      3328
#define XB_TOPGEN   3392
#define XCD_BAR_WORDS 3456
#define XB_SPIN_CAP (1u << 18)
__device__ __forceinline__ unsigned xb_ld(unsigned* p)              { return __hip_atomic_load(p, __ATOMIC_RELAXED, __HIP_MEMORY_SCOPE_AGENT); }
__device__ __forceinline__ unsigned xb_add(unsigned* p, unsigned v) { return __hip_atomic_fetch_add(p, v, __ATOMIC_RELAXED, __HIP_MEMORY_SCOPE_AGENT); }
__device__ __forceinline__ unsigned xb_xcc_id() { return (unsigned)__builtin_amdgcn_s_getreg((3 << 11) | 20) & 0xFu; }
#define XB_SPIN(cond, bar) do { unsigned _sp = 0; while (cond) { __builtin_amdgcn_s_sleep(1); \
    if ((++_sp & 255u) == 0u) { if (xb_ld(&(bar)[XB_TMO])) break; if (_sp > XB_SPIN_CAP) { atomicAdd(&(bar)[XB_TMO], 1u); break; } } } } while (0)
struct XcdBarrier { unsigned* bar; unsigned x; volatile LAS unsigned* st; };
__device__ __forceinline__ XcdBarrier xcd_barrier_post(unsigned* bar, volatile LAS unsigned* st) {
    XcdBarrier b; b.bar = bar; b.x = xb_xcc_id(); b.st = st;
    if (threadIdx.x == 0) (void)xb_add(&bar[XB_XCNT(b.x)], 1u);
    return b;
}
__device__ __forceinline__ void xcd_barrier_complete(unsigned* bar, unsigned x, unsigned& nloc, unsigned& nx) {
    const unsigned G = gridDim.x * gridDim.y * gridDim.z;
    unsigned sum, cnt, mine, sp = 0u;
    for (;;) {
        sum = 0u; cnt = 0u; mine = 0u;
#pragma unroll
        for (unsigned j = 0; j < 16; ++j) { const unsigned c = xb_ld(&bar[XB_XCNT(j)]); sum += c; cnt += (c > 0u) ? 1u : 0u; mine = (j == x) ? c : mine; }
        if (sum == G) break;
        __builtin_amdgcn_s_sleep(1);
        if ((++sp & 255u) == 0u) { if (xb_ld(&bar[XB_TMO])) break; if (sp > XB_SPIN_CAP) { atomicAdd(&bar[XB_TMO], 1u); break; } }
    }
    nloc = mine > 0u ? mine : 1u; nx = cnt > 0u ? cnt : 1u;
}
__device__ __forceinline__ void xcd_arrive(const XcdBarrier& b) {
    asm volatile("s_waitcnt vmcnt(0)" ::: "memory");
    __syncthreads();
    if (threadIdx.x == 0) {
        unsigned* bar = b.bar;
        __builtin_amdgcn_s_waitcnt(0);
        unsigned nloc = b.st[0], nx = b.st[1];
        if (nloc == 0u) { xcd_barrier_complete(bar, b.x, nloc, nx); b.st[0] = nloc; b.st[1] = nx; }
        const unsigned old = xb_add(&bar[XB_XSUB(b.x)], 1u);
        const unsigned gen = old / nloc;
        if (old + 1u == (gen + 1u) * nloc) {
            __builtin_amdgcn_fence(__ATOMIC_RELEASE, "agent");
            asm volatile("s_waitcnt vmcnt(0)" ::: "memory");
            const unsigned og = xb_add(&bar[XB_TOP], 1u);
            const unsigned tg = og / nx;
            if (og + 1u == (tg + 1u) * nx) xb_add(&bar[XB_TOPGEN], 1u);
            (void)tg;
        }
        b.st[3] = gen;
    }
}
__device__ __forceinline__ void xcd_wait(const XcdBarrier& b) {
    if (threadIdx.x == 0) {
        unsigned* bar = b.bar;
        const unsigned tok = b.st[3];
        XB_SPIN(xb_ld(&bar[XB_TOPGEN]) == tok, bar);
        __builtin_amdgcn_fence(__ATOMIC_ACQUIRE, "agent");
        asm volatile("s_waitcnt vmcnt(0)" ::: "memory");
    }
    __syncthreads();
}
__device__ __forceinline__ void xcd_barrier(const XcdBarrier& b) { xcd_arrive(b); xcd_wait(b); }
constexpr int CW_BAR = 4096;

struct Args {
    const float* in[15]; float* out; unsigned char* ws;
    double invf[8];
    int ph_lo, ph_hi;
};

__device__ __forceinline__ void p0_transpose_item(const float* W, int K, int N, bf16* WT, const float* g, LAS float* scr, int item, int lane) {
    const int nblk = N / 32, kb = item / nblk, nb = item % nblk, k0 = 64 * kb, n0 = 32 * nb;
    const int kr = lane >> 3, nq = lane & 7;
    const float* wp = W + (size_t)(k0 + kr) * N + n0 + 4 * nq;
    LAS float* dp = scr + kr * 33 + 4 * nq;
#pragma unroll
    for (int hb = 0; hb < 2; ++hb) {
        f32x4 wv[4];
#pragma unroll
        for (int i = 0; i < 4; ++i) wv[i] = *(const f32x4*)(wp + (size_t)(32 * hb + 8 * i) * N);
#pragma unroll
        for (int i = 0; i < 4; ++i) { const int kk = 32 * hb + 8 * i; const float gs = g ? g[k0 + kk + kr] : 1.0f; LAS float* d = dp + kk * 33;
            d[0] = wv[i][0] * gs; d[1] = wv[i][1] * gs; d[2] = wv[i][2] * gs; d[3] = wv[i][3] * gs; }
    }
    LDS_WAIT(); asm volatile("" ::: "memory");
    const int c = lane & 7;
#pragma unroll
    for (int j = 0; j < 4; ++j) { const int n = (lane >> 3) + 8 * j; const LAS float* s = scr + (8 * c) * 33 + n;
        v4u o; o.x = pg8::cvt_pk_bf16(s[0 * 33], s[1 * 33]); o.y = pg8::cvt_pk_bf16(s[2 * 33], s[3 * 33]); o.z = pg8::cvt_pk_bf16(s[4 * 33], s[5 * 33]); o.w = pg8::cvt_pk_bf16(s[6 * 33], s[7 * 33]);
        *(GAS v4u*)(WT + (size_t)(n0 + n) * K + k0 + 8 * c) = o; }
    LDS_WAIT(); asm volatile("" ::: "memory");
}

constexpr int I_IN = (D / 64) * (INW / 32), I_O = (D / 64) * (D / 32), I_UP = (D / 64) * (FF / 32), I_DN = (FF / 64) * (D / 32), PER_L = I_IN + I_O + I_UP + I_DN;
__device__ __forceinline__ void convert_weights(const Args& a, LAS unsigned char* lds, int gw, int NGW, int lo, int hi, int i0, int i1, int wave, int lane) {
    unsigned char* ws = a.ws;
    LAS float* scr = (LAS float*)(lds + RING_OFF + wave * 16384);
    for (int i = i0; i < i1; ++i) {
        const int it = lo + gw + i * NGW; if (it >= hi) break;
        const int l = it / PER_L; int r = it % PER_L;
        if (r < I_IN) { p0_transpose_item(a.in[6] + (size_t)l * D * INW, D, INW, (bf16*)(ws + WS_WIN) + (size_t)l * INW * D, a.in[5] + l * D, scr, r, lane); continue; } r -= I_IN;
        if (r < I_O)  { p0_transpose_item(a.in[10] + (size_t)l * D * D, D, D, (bf16*)(ws + WS_WO) + (size_t)l * D * D, nullptr, scr, r, lane); continue; } r -= I_O;
        if (r < I_UP) { p0_transpose_item(a.in[12] + (size_t)l * D * FF, D, FF, (bf16*)(ws + WS_WUP) + (size_t)l * FF * D, a.in[11] + l * D, scr, r, lane); continue; } r -= I_UP;
        p0_transpose_item(a.in[13] + (size_t)l * FF * D, FF, D, (bf16*)(ws + WS_WDN) + (size_t)l * D * FF, nullptr, scr, r, lane);
    }
}
__device__ __forceinline__ void copy_caches(const Args& a, int gt, int NGT, int i0, int i1) {
    constexpr int PER = 3968, TOTAL = DEPTH * DB * 2 * PER;
    for (int it = i0; it < i1; ++it) {
        const int b0 = gt + it * 8 * NGT; if (b0 >= TOTAL) break;
        f32x4 t[8];
#pragma unroll
        for (int u = 0; u < 8; ++u) { const int i = b0 + u * NGT; if (i < TOTAL) { const int slab = i / PER, w = i % PER, kv = slab & 1, ls = slab >> 1;
            t[u] = *((const GAS f32x4*)((kv ? a.in[3] : a.in[2]) + ((size_t)ls * 128 + 4) * 128) + w); } }
#pragma unroll
        for (int u = 0; u < 8; ++u) { const int i = b0 + u * NGT; if (i < TOTAL) { const int slab = i / PER, w = i % PER, kv = slab & 1, ls = slab >> 1;
            *((GAS f32x4*)(a.out + (kv ? OFF_NVS : OFF_NKS) + (size_t)ls * 128 * 128) + w) = t[u]; } }
    }
}
constexpr int CACHE_ITERS = 2;

__device__ __forceinline__ void phase_prologue(const Args& a, LAS unsigned char* lds, int vcu, int G, int wave, int lane, int tid) {
    unsigned char* ws = a.ws;
    const int gw = vcu * NWAVES + wave, NGW = G * NWAVES;
    convert_weights(a, lds, gw, NGW, 0, I_IN, 0, (I_IN + NGW - 1) / NGW, wave, lane);
    for (int m0 = gw; m0 < M; m0 += 2 * NGW) {
        f32x4 v[2][4];
#pragma unroll
        for (int u = 0; u < 2; ++u) { const int m = m0 + u * NGW; if (m < M) {
            const float* xrow = (m < NTP) ? a.in[0] + (size_t)m * D : a.in[1] + (size_t)(m - NTP) * D;
            const GAS f32x4* xr = (const GAS f32x4*)xrow + lane;
#pragma unroll
            for (int j = 0; j < 4; ++j) v[u][j] = xr[64 * j]; } }
#pragma unroll
        for (int u = 0; u < 2; ++u) { const int m = m0 + u * NGW; if (m < M) {
            float s = 0.f;
#pragma unroll
            for (int j = 0; j < 4; ++j) s += (v[u][j].x * v[u][j].x + v[u][j].y * v[u][j].y) + (v[u][j].z * v[u][j].z + v[u][j].w * v[u][j].w);
            s = wave_sum(s);
            GAS unsigned long long* o8 = (GAS unsigned long long*)((bf16*)(ws + WS_XB) + (size_t)m * D) + lane;
#pragma unroll
            for (int j = 0; j < 4; ++j) o8[64 * j] = (unsigned long long)pg8::cvt_pk_bf16(v[u][j].x, v[u][j].y) | ((unsigned long long)pg8::cvt_pk_bf16(v[u][j].z, v[u][j].w) << 32);
            if (lane < 16) ((float*)(ws + WS_SSQ))[(size_t)m * 16 + lane] = (lane == 0) ? s : 0.f; } }
    }
    const int gt = vcu * (NWAVES * 64) + tid, NGT = G * NWAVES * 64;
    for (int i = gt; i < NPOS * 8; i += NGT) {
        const int p = i >> 3, j = i & 7; const int pos = p < 4096 ? p : PASTLEN + (p - 4096);
        const double rev = (double)pos * a.invf[j] * 0.15915494309189535; const float fr = (float)(rev - rint(rev));
        float* rt = (float*)(ws + WS_ROT) + (size_t)i * 2; rt[0] = __builtin_amdgcn_cosf(fr); rt[1] = __builtin_amdgcn_sinf(fr);
    }
    for (int i = gt; i < 512; i += NGT) {
        const float a0 = a.in[8][i], a1 = a.in[8][512 + i], mx = fmaxf(a0, a1), e0 = expf(a0 - mx), e1 = expf(a1 - mx), p0 = e0 / (e0 + e1), p1 = e1 / (e0 + e1);
        float* lbp = (float*)(ws + WS_LB); lbp[i] = fmaxf(p0 - p0, 0.f); lbp[512 + i] = fmaxf((p0 + p1) - p0, 0.f);
    }
}

__device__ __forceinline__ void phase_final_norm(const Args& a, int vcu, int G, int wave, int lane) {
    const int gw = vcu * NWAVES + wave, NGW = G * NWAVES;
    const GAS f32x4* gp = (const GAS f32x4*)a.in[14] + lane;
    f32x4 g[4];
#pragma unroll
    for (int j = 0; j < 4; ++j) g[j] = gp[64 * j];
    for (int m = gw; m < M; m += NGW) {
        const GAS pg8::u32x2* xr = (const GAS pg8::u32x2*)((const bf16*)(a.ws + WS_XB) + (size_t)m * D) + lane;
        GAS f32x4* yr = (GAS f32x4*)(a.out + (size_t)m * D) + lane;
        f32x4 v[4]; float s = 0.f;
#pragma unroll
        for (int j = 0; j < 4; ++j) { const pg8::u32x2 w = xr[64 * j];
            v[j] = (f32x4){__builtin_bit_cast(float, w.x << 16), __builtin_bit_cast(float, w.x & 0xffff0000u), __builtin_bit_cast(float, w.y << 16), __builtin_bit_cast(float, w.y & 0xffff0000u)};
            s += (v[j].x * v[j].x + v[j].y * v[j].y) + (v[j].z * v[j].z + v[j].w * v[j].w); }
        const float rstd = __builtin_amdgcn_rsqf(wave_sum(s) * (1.0f / D) + EPS);
#pragma unroll
        for (int j = 0; j < 4; ++j) yr[64 * j] = v[j] * rstd * g[j];
    }
}

namespace att {
typedef short bf16x8 __attribute__((ext_vector_type(8)));
typedef short s16x4 __attribute__((ext_vector_type(4)));
typedef float f32x16 __attribute__((ext_vector_type(16)));
constexpr int QP = 528, KP = 144, VP = 192, Q_OFF = 0, K_OFF = 64 * QP, V_OFF = K_OFF + 192 * KP, O_OFF = V_OFF + 192 * VP, LDS_NEED = O_OFF + 8 * 4096;
static_assert(LDS_NEED <= RING_BYTES, "attention LDS map");
__device__ __forceinline__ s16x4 tr16(LAS const unsigned char* p) { return __builtin_bit_cast(s16x4, __builtin_amdgcn_ds_read_tr16_b64_v4i16((LAS s16x4*)p)); }
__device__ __forceinline__ v4u pack8(const f32x4 a, const f32x4 b) { v4u r; r.x = pkb(a[0], a[1]); r.y = pkb(a[2], a[3]); r.z = pkb(b[0], b[1]); r.w = pkb(b[2], b[3]); return r; }
#define U_PROMPT(un) ((un) < 512)
#define U_KVH(un) ((un) & 1)
#define U_Q0(un) ((((un) >> 1) & 63) * 64)
#define U_B(un) ((un) >> 7)
#define U_SB(un) (((un) - 512) >> 1)
__device__ __forceinline__ void load_unit(const int un, const bf16* PROJ, const int tid, v4u (&pf)[6], v4u (&pq)[4]) {
    const int kvh = U_KVH(un);
    if (U_PROMPT(un)) {
        const int q0 = U_Q0(un), b = U_B(un);
#pragma unroll
        for (int i = 0; i < 3; ++i) {
            const int idx = tid + 512 * i, kk = idx >> 3, c = idx & 7, tk = q0 - 128 + kk;
            pf[2 * i] = (v4u){0u, 0u, 0u, 0u}; pf[2 * i + 1] = pf[2 * i];
            if (tk >= 0) { const bf16* rp = PROJ + (size_t)(b * SEQ + tk) * INW; pf[2 * i] = *(const v4u*)(rp + C_KA + kvh * 64 + c * 8); pf[2 * i + 1] = *(const v4u*)(rp + C_VA + kvh * 64 + c * 8); }
        }
#pragma unroll
        for (int i = 0; i < 4; ++i) { const int idx = tid + 512 * i, r = idx >> 5, c16 = idx & 31; pq[i] = *(const v4u*)(PROJ + (size_t)(b * SEQ + q0 + r) * INW + C_QA + kvh * 256 + c16 * 8); }
    } else {
        pq[0] = (v4u){0u, 0u, 0u, 0u};
        if (tid < 128) pq[0] = *(const v4u*)(PROJ + (size_t)(NTP + U_SB(un) * 4 + (tid >> 5)) * INW + C_QA + kvh * 256 + (tid & 31) * 8);
    }
}
__device__ __forceinline__ void store_unit(const int un, LAS unsigned char* lds, const int tid, const v4u (&pf)[6], const v4u (&pq)[4]) {
    if (U_PROMPT(un)) {
#pragma unroll
        for (int i = 0; i < 3; ++i) { const int idx = tid + 512 * i, kk = idx >> 3, c = idx & 7; *(LAS v4u*)(lds + K_OFF + kk * KP + c * 16) = pf[2 * i]; *(LAS v4u*)(lds + V_OFF + kk * VP + c * 16) = pf[2 * i + 1]; }
#pragma unroll
        for (int i = 0; i < 4; ++i) { const int idx = tid + 512 * i, r = idx >> 5, c16 = idx & 31; *(LAS v4u*)(lds + Q_OFF + r * QP + c16 * 16) = pq[i]; }
    } else if (tid < 128) *(LAS v4u*)(lds + Q_OFF + (tid >> 5) * QP + (tid & 31) * 16) = pq[0];
}
__device__ __forceinline__ void stage_sample(const int un, LAS unsigned char* lds, const bf16* PROJ, const float* ck, const float* cv, const int tid) {
    const int sb = U_SB(un), kvh = U_KVH(un);
#pragma unroll
    for (int i = 0; i < 3; ++i) {
        const int idx = tid + 512 * i, kk = idx >> 3, c = idx & 7;
        v4u kx = (v4u){0u, 0u, 0u, 0u}, vx = kx;
        if (kk < 128) { const size_t o = ((size_t)(sb * 128 + kk) * 2 + kvh) * 64 + c * 8;
            kx = pack8(*(const f32x4*)(ck + o), *(const f32x4*)(ck + o + 4)); vx = pack8(*(const f32x4*)(cv + o), *(const f32x4*)(cv + o + 4)); }
        else if (kk < 132) { const bf16* rp = PROJ + (size_t)(NTP + sb * 4 + (kk - 128)) * INW; kx = *(const v4u*)(rp + C_KA + kvh * 64 + c * 8); vx = *(const v4u*)(rp + C_VA + kvh * 64 + c * 8); }
        *(LAS v4u*)(lds + K_OFF + kk * KP + c * 16) = kx; *(LAS v4u*)(lds + V_OFF + kk * VP + c * 16) = vx;
    }
}
template <int LEVEL>
__device__ __forceinline__ void compute(LAS unsigned char* lds, const bool active, const int hq, const int hl, const int qlrow, const size_t orow0, const int nvalid,
                                        const int kk0, const int klo, const int khi, const float* sinks, bf16* MIXB, const int lane, const int wave) {
    const int ql = lane & 31, h = lane >> 5;
    if (active && LEVEL >= 2) {
        bf16x8 qf[4];
#pragma unroll
        for (int ks = 0; ks < 4; ++ks) qf[ks] = *(const LAS bf16x8*)(lds + Q_OFF + qlrow * QP + (hl * 64 + 16 * ks + 8 * h) * 2);
        f32x16 s[5];
#pragma unroll
        for (int kt = 0; kt < 5; ++kt) {
            s[kt] = (f32x16){0.f, 0.f, 0.f, 0.f, 0.f, 0.f, 0.f, 0.f, 0.f, 0.f, 0.f, 0.f, 0.f, 0.f, 0.f, 0.f};
#pragma unroll
            for (int ks = 0; ks < 4; ++ks) { const bf16x8 a = *(const LAS bf16x8*)(lds + K_OFF + (kk0 + 32 * kt + ql) * KP + (16 * ks + 8 * h) * 2); s[kt] = __builtin_amdgcn_mfma_f32_32x32x16_bf16(a, qf[ks], s[kt], 0, 0, 0); }
        }
        if constexpr (LEVEL == 2) { asm volatile("" :: "v"(s[0]), "v"(s[1]), "v"(s[2]), "v"(s[3]), "v"(s[4])); return; }
        float mx = -INFINITY;
#pragma unroll
        for (int kt = 0; kt < 5; ++kt)
#pragma unroll
            for (int r = 0; r < 16; ++r) { const int kk = kk0 + 32 * kt + (r & 3) + 8 * (r >> 2) + 4 * h; const bool ok = (kk >= klo) && (kk <= khi); const float v = ok ? s[kt][r] : -INFINITY; s[kt][r] = v; mx = fmaxf(mx, v); }
        mx = fmaxf(mx, __shfl_xor(mx, 32));
        const float sk = sinks[hq] * LOG2E; mx = fmaxf(mx, sk);
        float sum = 0.f;
#pragma unroll
        for (int kt = 0; kt < 5; ++kt)
#pragma unroll
            for (int r = 0; r < 16; ++r) { const float p = __builtin_amdgcn_exp2f(s[kt][r] - mx); s[kt][r] = p; sum += p; }
        sum += __shfl_xor(sum, 32); sum += __builtin_amdgcn_exp2f(sk - mx);
        const float inv = __builtin_amdgcn_rcpf(sum);
        if constexpr (LEVEL == 3) { asm volatile("" :: "v"(s[0]), "v"(s[1]), "v"(s[2]), "v"(s[3]), "v"(s[4]), "v"(inv)); return; }
        f32x16 o[2];
        o[0] = (f32x16){0.f, 0.f, 0.f, 0.f, 0.f, 0.f, 0.f, 0.f, 0.f, 0.f, 0.f, 0.f, 0.f, 0.f, 0.f, 0.f}; o[1] = o[0];
        const int vrow = 4 * h + ((lane & 15) >> 2), vcol = 16 * ((lane >> 4) & 1) + 4 * (lane & 3);
#pragma unroll
        for (int kt = 0; kt < 5; ++kt)
#pragma unroll
            for (int st = 0; st < 2; ++st) {
                v4u pw; pw.x = pkb(s[kt][8 * st + 0], s[kt][8 * st + 1]); pw.y = pkb(s[kt][8 * st + 2], s[kt][8 * st + 3]); pw.z = pkb(s[kt][8 * st + 4], s[kt][8 * st + 5]); pw.w = pkb(s[kt][8 * st + 6], s[kt][8 * st + 7]);
                const bf16x8 pb = __builtin_bit_cast(bf16x8, pw);
#pragma unroll
                for (int mt = 0; mt < 2; ++mt) {
                    const LAS unsigned char* vp = lds + V_OFF + (kk0 + 32 * kt + 16 * st + vrow) * VP + (32 * mt + vcol) * 2;
                    const s16x4 lo = tr16(vp), hi = tr16(vp + 8 * VP);
                    const bf16x8 a = (bf16x8){lo[0], lo[1], lo[2], lo[3], hi[0], hi[1], hi[2], hi[3]};
                    o[mt] = __builtin_amdgcn_mfma_f32_32x32x16_bf16(a, pb, o[mt], 0, 0, 0);
                }
            }
        if constexpr (LEVEL == 4) { asm volatile("" :: "v"(o[0]), "v"(o[1]), "v"(inv)); return; }
        LAS unsigned char* ost = lds + O_OFF + wave * 4096;
#pragma unroll
        for (int mt = 0; mt < 2; ++mt)
#pragma unroll
            for (int rg = 0; rg < 4; ++rg) { pg8::u32x2 wv; wv.x = pkb(o[mt][4 * rg] * inv, o[mt][4 * rg + 1] * inv); wv.y = pkb(o[mt][4 * rg + 2] * inv, o[mt][4 * rg + 3] * inv);
                *(LAS pg8::u32x2*)(ost + ql * 128 + (((4 * mt + rg) ^ (ql & 7)) * 16) + h * 8) = wv; }
        LDS_WAIT();
#pragma unroll
        for (int i = 0; i < 4; ++i) { const int row = (lane >> 3) + 8 * i, ch = lane & 7;
            const v4u v = *(const LAS v4u*)(ost + row * 128 + ((ch ^ (row & 7)) * 16));
            if (row < nvalid) *(v4u*)(MIXB + (orow0 + row) * D + hq * 64 + ch * 8) = v; }
    }
}
template <int LEVEL>
__device__ __forceinline__ void run(LAS unsigned char* lds, const bf16* PROJ, const float* ck, const float* cv, const float* sinks, bf16* MIXB, bf16* MIXS, const int first, const int stride, const int nun, const int tid) {
    if (first >= nun) return;
    const int lane = tid & 63, wave = __builtin_amdgcn_readfirstlane(tid >> 6), ql = lane & 31;
    v4u pf[6], pq[4];
    int un = first;
    load_unit(un, PROJ, tid, pf, pq);
    for (;;) {
        store_unit(un, lds, tid, pf, pq);
        if (!U_PROMPT(un)) stage_sample(un, lds, PROJ, ck, cv, tid);
        WG_BAR();
        const int nxt = un + stride; const bool more = nxt < nun;
        if (more) load_unit(nxt, PROJ, tid, pf, pq);
        const int kvh = U_KVH(un);
        if (U_PROMPT(un)) { const int half = wave & 1, q0 = U_Q0(un); int klo = 32 * half + ql; if (128 - q0 > klo) klo = 128 - q0;
            compute<LEVEL>(lds, true, kvh * 4 + (wave >> 1), wave >> 1, 32 * half + ql, (size_t)U_B(un) * SEQ + q0 + 32 * half, 32, 32 * half, klo, 128 + 32 * half + ql, sinks, MIXB, lane, wave); }
        else { const bool v = ql < 4;
            compute<LEVEL>(lds, wave < 4, kvh * 4 + (wave & 3), wave & 3, ql & 3, (size_t)NTP + U_SB(un) * 4, 4, 0, v ? ql : 1, v ? 128 + ql : 0, sinks, MIXS, lane, wave); }
        WG_BAR();
        if (!more) break;
        un = nxt;
    }
}
}

namespace hg {
typedef short bf16x8 __attribute__((ext_vector_type(8)));
typedef short s16x4 __attribute__((ext_vector_type(4)));
typedef unsigned u32x2 __attribute__((ext_vector_type(2)));
constexpr int PQ = 272, PT = 320;
constexpr int T_Q = 0, T_KR = 8704, T_LF = 17408, T_KD = 27648, T_V = 37888, T_G = 48128, O_DEC = 56832, O_SSQ = 57344, LDS_NEED = 58368;
__device__ __forceinline__ s16x4 tr16(LAS const unsigned char* p) { return __builtin_bit_cast(s16x4, __builtin_amdgcn_ds_read_tr16_b64_v4i16((LAS s16x4*)p)); }
__device__ __forceinline__ float row16_sum(float v) {
    v += __builtin_bit_cast(float, __builtin_amdgcn_update_dpp(0, __builtin_bit_cast(int, v), 0x128, 0xf, 0xf, false));
    v += __builtin_bit_cast(float, __builtin_amdgcn_update_dpp(0, __builtin_bit_cast(int, v), 0x124, 0xf, 0xf, false));
    v += __builtin_bit_cast(float, __builtin_amdgcn_update_dpp(0, __builtin_bit_cast(int, v), 0x122, 0xf, 0xf, false));
    v += __builtin_bit_cast(float, __builtin_amdgcn_update_dpp(0, __builtin_bit_cast(int, v), 0x121, 0xf, 0xf, false));
    return v;
}
__device__ __forceinline__ bf16x8 cat(const s16x4 a, const s16x4 b) { return (bf16x8){a[0], a[1], a[2], a[3], b[0], b[1], b[2], b[3]}; }
__device__ __forceinline__ float ldsbf(LAS const unsigned char* p) { return bf2f(*(const LAS bf16*)p); }
__device__ __forceinline__ void stsbf(LAS unsigned char* p, float v) { *(LAS bf16*)p = (bf16)pkb(v, v); }
__device__ __forceinline__ bf16x8 pack8f(const f32x4 a, const f32x4 b) { v4u r; r.x = pkb(a[0], a[1]); r.y = pkb(a[2], a[3]); r.z = pkb(b[0], b[1]); r.w = pkb(b[2], b[3]); return __builtin_bit_cast(bf16x8, r); }

__device__ __forceinline__ void chunk_cumsum(LAS const unsigned char* lds, int d0, int lane, f32x4 (&bacc)[2]) {
    const int c = lane & 15, g = lane >> 4;
    const LAS unsigned char* p = lds + T_LF + (8 * g + (c >> 2)) * PT + (d0 + 4 * (c & 3)) * 2;
    const bf16x8 lfb = cat(tr16(p), tr16(p + 4 * PT));
#pragma unroll
    for (int mt = 0; mt < 2; ++mt) {
        const int t = 16 * mt + c; bf16x8 L;
#pragma unroll
        for (int j = 0; j < 8; ++j) L[j] = (8 * g + j <= t) ? (short)0x3F80 : (short)0;
        bacc[mt] = __builtin_amdgcn_mfma_f32_16x16x32_bf16(L, lfb, (f32x4){0.f, 0.f, 0.f, 0.f}, 0, 0, 0);
    }
}

__device__ __forceinline__ void pass1_item(LAS unsigned char* lds, const bf16* PROJ, float* USEG, float* DSEG, const int it, const int tid) {
    const int lane = tid & 63, wave = __builtin_amdgcn_readfirstlane(tid >> 6), c = lane & 15, g = lane >> 4, d0 = 16 * wave;
    const int chain = it >> 4, seg = it & 15, b = chain >> 2, h = chain & 3;
    const size_t row0 = (size_t)b * SEQ + seg * 256;
    const int srow = tid >> 4, sc16 = tid & 15;
    const bf16* gl = PROJ + (row0 + srow) * INW + h * 128 + sc16 * 8;
    v4u rl = *(const v4u*)(gl + C_FH), rv = *(const v4u*)(gl + C_IH);
    f32x4 S[8];
#pragma unroll
    for (int m = 0; m < 8; ++m) S[m] = (f32x4){0.f, 0.f, 0.f, 0.f};
    float logD = 0.f;
    for (int ch = 0; ch < 8; ++ch) {
        *(LAS v4u*)(lds + T_LF + srow * PT + sc16 * 16) = rl; *(LAS v4u*)(lds + T_V + srow * PT + sc16 * 16) = rv;
        if (ch < 7) { const bf16* gn = gl + (size_t)(ch + 1) * 32 * INW; rl = *(const v4u*)(gn + C_FH); rv = *(const v4u*)(gn + C_IH); }
        WG_BAR();
        f32x4 bacc[2]; chunk_cumsum(lds, d0, lane, bacc);
        const float blast = __shfl(bacc[1][3], 48 + c);
        logD += blast;
#pragma unroll
        for (int mt = 0; mt < 2; ++mt)
#pragma unroll
            for (int r = 0; r < 4; ++r) { const int t = 16 * mt + 4 * g + r; const float lf = ldsbf(lds + T_LF + t * PT + (d0 + c) * 2);
                stsbf(lds + T_KD + t * PT + (d0 + c) * 2, (1.0f - __builtin_amdgcn_exp2f(lf)) * __builtin_amdgcn_exp2f(blast - bacc[mt][r])); }
        if (g == 0) *(LAS float*)(lds + O_DEC + (d0 + c) * 4) = __builtin_amdgcn_exp2f(blast);
        WG_BAR();
        const LAS unsigned char* vp = lds + T_V + (4 * g + (c >> 2)) * PT + (d0 + 4 * (c & 3)) * 2;
        const bf16x8 vf = cat(tr16(vp), tr16(vp + 16 * PT));
#pragma unroll
        for (int m = 0; m < 8; ++m) {
            const f32x4 dc = *(const LAS f32x4*)(lds + O_DEC + (16 * m + 4 * g) * 4);
            const LAS unsigned char* kp = lds + T_KD + (4 * g + (c >> 2)) * PT + (16 * m + 4 * (c & 3)) * 2;
            const bf16x8 kf = cat(tr16(kp), tr16(kp + 16 * PT));
            S[m] = __builtin_amdgcn_mfma_f32_16x16x32_bf16(kf, vf, S[m] * dc, 0, 0, 0);
        }
        WG_BAR();
    }
    float* U = USEG + (size_t)it * 16384;
#pragma unroll
    for (int m = 0; m < 8; ++m)
#pragma unroll
        for (int r = 0; r < 4; ++r) U[(size_t)(16 * m + 4 * g + r) * 128 + d0 + c] = S[m][r];
    if (g == 0) DSEG[(size_t)it * 128 + d0 + c] = __builtin_amdgcn_exp2f(logD);
}

__device__ __forceinline__ void combine_phase(float* USEG, const float* DSEG, float* ns_p, int gt, int NGT) {
    for (int e = gt; e < 16 * 16384; e += NGT) {
        const int chain = e >> 14, idx = e & 16383, dk = idx >> 7;
        float u[16], dcy[16];
#pragma unroll
        for (int sg = 0; sg < 16; ++sg) { u[sg] = USEG[((size_t)(chain * 16 + sg) << 14) + idx]; dcy[sg] = DSEG[(size_t)(chain * 16 + sg) * 128 + dk]; }
        float S = 0.f;
#pragma unroll
        for (int sg = 0; sg < 16; ++sg) { USEG[((size_t)(chain * 16 + sg) << 14) + idx] = S; S = dcy[sg] * S + u[sg]; }
        ns_p[(size_t)chain * 16384 + idx] = S;
    }
}

constexpr int SET_BYTES = LDS_NEED;
static_assert(2 * SET_BYTES <= RING_BYTES, "two HGRN tile sets must fit the LDS ring");
__device__ __forceinline__ void p2_prepare(LAS unsigned char* lds, const int d0, const int lane) {
    const int c = lane & 15, g = lane >> 4;
    f32x4 bacc[2]; chunk_cumsum(lds, d0, lane, bacc);
    const float blast = __shfl(bacc[1][3], 48 + c);
#pragma unroll
    for (int mt = 0; mt < 2; ++mt)
#pragma unroll
        for (int r = 0; r < 4; ++r) { const int t = 16 * mt + 4 * g + r; const float bv = bacc[mt][r];
            const float lf = ldsbf(lds + T_LF + t * PT + (d0 + c) * 2), q = ldsbf(lds + T_Q + t * PQ + (d0 + c) * 2), k = 1.0f - __builtin_amdgcn_exp2f(lf);
            stsbf(lds + T_Q + t * PQ + (d0 + c) * 2, q * __builtin_amdgcn_exp2f(bv));
            stsbf(lds + T_KR + t * PQ + (d0 + c) * 2, k * __builtin_amdgcn_exp2f(fminf(-bv, 115.f)));
            stsbf(lds + T_KD + t * PT + (d0 + c) * 2, k * __builtin_amdgcn_exp2f(blast - bv)); }
    if (g == 0) *(LAS float*)(lds + O_DEC + (d0 + c) * 4) = __builtin_amdgcn_exp2f(blast);
}
__device__ __forceinline__ void pass2_item(LAS unsigned char* lds0, const bf16* PROJ, const float* USEG, const float* onorm, bf16* MIXB, const int it, const int tid) {
    const int lane = tid & 63, wave = __builtin_amdgcn_readfirstlane(tid >> 6), c = lane & 15, g = lane >> 4, d0 = 16 * wave;
    const int chain = it >> 4, seg = it & 15, b = chain >> 2, h = chain & 3;
    const size_t row0 = (size_t)b * SEQ + seg * 256;
    const int srow = tid >> 4, sc16 = tid & 15;
    const bf16* gl = PROJ + (row0 + srow) * INW + h * 128 + sc16 * 8;
    v4u rq = *(const v4u*)(gl + C_QH), rl = *(const v4u*)(gl + C_FH), rv = *(const v4u*)(gl + C_IH), rg = *(const v4u*)(gl + C_GH);
    f32x4 S[8];
    { const float* U = USEG + (size_t)it * 16384;
#pragma unroll
      for (int m = 0; m < 8; ++m)
#pragma unroll
          for (int r = 0; r < 4; ++r) S[m][r] = U[(size_t)(16 * m + 4 * g + r) * 128 + d0 + c]; }
    const float gn = onorm[d0 + c];
#define P2_WRITE_RAW(base) do { *(LAS v4u*)((base) + T_Q + srow * PQ + sc16 * 16) = rq; *(LAS v4u*)((base) + T_LF + srow * PT + sc16 * 16) = rl; \
        *(LAS v4u*)((base) + T_V + srow * PT + sc16 * 16) = rv; *(LAS v4u*)((base) + T_G + srow * PQ + sc16 * 16) = rg; } while (0)
#define P2_LOAD_RAW(ch) do { const bf16* gnx = gl + (size_t)(ch) * 32 * INW; rq = *(const v4u*)(gnx + C_QH); rl = *(const v4u*)(gnx + C_FH); rv = *(const v4u*)(gnx + C_IH); rg = *(const v4u*)(gnx + C_GH); } while (0)
    P2_WRITE_RAW(lds0); P2_LOAD_RAW(1);
    WG_BAR();
    p2_prepare(lds0, d0, lane);
    WG_BAR();
    for (int ch = 0; ch < 8; ++ch) {
        LAS unsigned char* lds = lds0 + (ch & 1) * SET_BYTES;
        LAS unsigned char* ldn = lds0 + ((ch & 1) ^ 1) * SET_BYTES;
        if (ch < 7) { P2_WRITE_RAW(ldn); if (ch < 6) P2_LOAD_RAW(ch + 2); }
        f32x4 o[2]; o[0] = (f32x4){0.f, 0.f, 0.f, 0.f}; o[1] = o[0];
#pragma unroll
        for (int ks = 0; ks < 4; ++ks) {
            const bf16x8 sb = pack8f(S[2 * ks], S[2 * ks + 1]);
#pragma unroll
            for (int mt = 0; mt < 2; ++mt) {
                const LAS unsigned char* qp = lds + T_Q + (16 * mt + c) * PQ + (32 * ks + 4 * g) * 2;
                const s16x4 a0 = *(const LAS s16x4*)qp, a1 = *(const LAS s16x4*)(qp + 32);
                o[mt] = __builtin_amdgcn_mfma_f32_16x16x32_bf16(cat(a0, a1), sb, o[mt], 0, 0, 0);
            }
        }
        f32x4 at[2][2];
#pragma unroll
        for (int ms = 0; ms < 2; ++ms)
#pragma unroll
            for (int nt = 0; nt < 2; ++nt) at[ms][nt] = (f32x4){0.f, 0.f, 0.f, 0.f};
#pragma unroll
        for (int ks = 0; ks < 4; ++ks) {
            bf16x8 ka[2], qb[2];
#pragma unroll
            for (int i = 0; i < 2; ++i) { ka[i] = *(const LAS bf16x8*)(lds + T_KR + (16 * i + c) * PQ + (32 * ks + 8 * g) * 2); qb[i] = *(const LAS bf16x8*)(lds + T_Q + (16 * i + c) * PQ + (32 * ks + 8 * g) * 2); }
#pragma unroll
            for (int ms = 0; ms < 2; ++ms)
#pragma unroll
                for (int nt = 0; nt < 2; ++nt) at[ms][nt] = __builtin_amdgcn_mfma_f32_16x16x32_bf16(ka[ms], qb[nt], at[ms][nt], 0, 0, 0);
        }
#pragma unroll
        for (int ms = 0; ms < 2; ++ms)
#pragma unroll
            for (int nt = 0; nt < 2; ++nt)
#pragma unroll
                for (int r = 0; r < 4; ++r) if (16 * ms + 4 * g + r > 16 * nt + c) at[ms][nt][r] = 0.f;
        const LAS unsigned char* vp = lds + T_V + (4 * g + (c >> 2)) * PT + (d0 + 4 * (c & 3)) * 2;
        const bf16x8 vf = cat(tr16(vp), tr16(vp + 16 * PT));
#pragma unroll
        for (int mt = 0; mt < 2; ++mt) o[mt] = __builtin_amdgcn_mfma_f32_16x16x32_bf16(pack8f(at[0][mt], at[1][mt]), vf, o[mt], 0, 0, 0);
#pragma unroll
        for (int m = 0; m < 8; ++m) {
            const f32x4 dc = *(const LAS f32x4*)(lds + O_DEC + (16 * m + 4 * g) * 4);
            const LAS unsigned char* kp = lds + T_KD + (4 * g + (c >> 2)) * PT + (16 * m + 4 * (c & 3)) * 2;
            S[m] = __builtin_amdgcn_mfma_f32_16x16x32_bf16(cat(tr16(kp), tr16(kp + 16 * PT)), vf, S[m] * dc, 0, 0, 0);
        }
#pragma unroll
        for (int mt = 0; mt < 2; ++mt)
#pragma unroll
            for (int r = 0; r < 4; ++r) { const float q2 = row16_sum(o[mt][r] * o[mt][r]);
                if (c == 0) *(LAS float*)(lds + O_SSQ + ((16 * mt + 4 * g + r) * 8 + wave) * 4) = q2; }
        WG_BAR();
        if (ch < 7) p2_prepare(ldn, d0, lane);
#pragma unroll
        for (int mt = 0; mt < 2; ++mt)
#pragma unroll
            for (int r = 0; r < 4; ++r) { const int t = 16 * mt + 4 * g + r;
                const f32x4 p0 = *(const LAS f32x4*)(lds + O_SSQ + t * 32), p1 = *(const LAS f32x4*)(lds + O_SSQ + t * 32 + 16);
                const float tot = ((p0[0] + p0[1]) + (p0[2] + p0[3])) + ((p1[0] + p1[1]) + (p1[2] + p1[3]));
                const float rstd = __builtin_amdgcn_rsqf(tot * (1.0f / 128.0f) + EPS);
                const float gate = ldsbf(lds + T_G + t * PQ + (d0 + c) * 2);
                stsbf(lds + T_KR + t * PQ + (d0 + c) * 2, o[mt][r] * rstd * gn * gate); }
        WG_BAR();
        *(v4u*)(MIXB + (row0 + ch * 32 + srow) * D + 512 + h * 128 + sc16 * 8) = *(const LAS v4u*)(lds + T_KR + srow * PQ + sc16 * 16);
    }
#undef P2_WRITE_RAW
#undef P2_LOAD_RAW
}

__device__ __forceinline__ void sample_load(const bf16* PROJ, const float* st_in, const int it, const int tid, f32x4 (&S)[8], v4u (&lw)[DS], v4u (&qw)[DS], u32x2 (&vw)[DS]) {
    const int dvq = tid & 31, rgp = tid >> 5, sb = it >> 2, h = it & 3;
    const size_t so = ((size_t)(sb * 4 + h) * 128 + rgp * 8) * 128 + 4 * dvq;
#pragma unroll
    for (int r = 0; r < 8; ++r) S[r] = *(const f32x4*)(st_in + so + (size_t)r * 128);
#pragma unroll
    for (int t = 0; t < DS; ++t) { const bf16* rp = PROJ + (size_t)(NTP + sb * 4 + t) * INW + h * 128;
        lw[t] = *(const v4u*)(rp + C_FH + rgp * 8); qw[t] = *(const v4u*)(rp + C_QH + rgp * 8); vw[t] = *(const u32x2*)(rp + C_IH + 4 * dvq); }
}
__device__ __forceinline__ void sample_compute(LAS unsigned char* lds, const bf16* PROJ, float* st_out, const float* onorm, bf16* MIXB, const int it, const int tid,
                                               f32x4 (&S)[8], const v4u (&lw)[DS], const v4u (&qw)[DS], const u32x2 (&vw)[DS]) {
    const int lane = tid & 63, wave = __builtin_amdgcn_readfirstlane(tid >> 6), dvq = tid & 31, rgp = tid >> 5;
    const int sb = it >> 2, h = it & 3;
    const size_t so = ((size_t)(sb * 4 + h) * 128 + rgp * 8) * 128 + 4 * dvq;
    LAS float* red = (LAS float*)lds; LAS float* osh = red + 16 * 128;
#pragma unroll
    for (int t = 0; t < DS; ++t) {
        const f32x4 v4 = (f32x4){__builtin_bit_cast(float, vw[t].x << 16), __builtin_bit_cast(float, vw[t].x & 0xffff0000u), __builtin_bit_cast(float, vw[t].y << 16), __builtin_bit_cast(float, vw[t].y & 0xffff0000u)};
        f32x4 po = (f32x4){0.f, 0.f, 0.f, 0.f};
#pragma unroll
        for (int r = 0; r < 8; ++r) { const unsigned lwd = lw[t][r >> 1], qwd = qw[t][r >> 1];
            const float lf = __builtin_bit_cast(float, (r & 1) ? (lwd & 0xffff0000u) : (lwd << 16)), q = __builtin_bit_cast(float, (r & 1) ? (qwd & 0xffff0000u) : (qwd << 16));
            const float f = __builtin_amdgcn_exp2f(lf), k = 1.0f - f;
            S[r] = S[r] * f + v4 * k; po += S[r] * q; }
        *(LAS f32x4*)(red + (t * 16 + rgp) * 128 + 4 * dvq) = po;
    }
#pragma unroll
    for (int r = 0; r < 8; ++r) *(f32x4*)(st_out + so + (size_t)r * 128) = S[r];
    WG_BAR();
    { const int t = tid >> 7, e = tid & 127; float a = 0.f;
#pragma unroll
      for (int j = 0; j < 16; ++j) a += red[(t * 16 + j) * 128 + e];
      osh[t * 128 + e] = a; }
    WG_BAR();
    if (wave < DS) { const int t = wave; const float a = osh[t * 128 + lane], b2 = osh[t * 128 + 64 + lane];
        const float rstd = __builtin_amdgcn_rsqf(wave_sum(a * a + b2 * b2) * (1.0f / 128.0f) + EPS);
        const size_t m = (size_t)NTP + sb * 4 + t; const bf16* gp = PROJ + m * INW + C_GH + h * 128;
        MIXB[m * D + 512 + h * 128 + lane] = (bf16)pkb1(a * rstd * onorm[lane] * bf2f(gp[lane]));
        MIXB[m * D + 512 + h * 128 + 64 + lane] = (bf16)pkb1(b2 * rstd * onorm[64 + lane] * bf2f(gp[64 + lane])); }
    WG_BAR();
}
}

namespace sg {
typedef short bf16x8 __attribute__((ext_vector_type(8)));
typedef unsigned u32x2 __attribute__((ext_vector_type(2)));
constexpr int CP = 1040, A_OFF = 0, B_OFF = 32 * CP, RED_OFF = B_OFF;
__device__ __forceinline__ void load_chunk(v4u (&r)[12], const bf16* A, const bf16* Bt, const int K, const int ntn, const int it, const int ch, const int tid) {
    const int tm = it / ntn, tn = it % ntn, row = tid >> 6, c16 = tid & 63;
    const bf16* ap = A + (size_t)(tm * 32 + row) * K + ch * 512 + c16 * 8;
    const bf16* bp = Bt + (size_t)(tn * 64 + row) * K + ch * 512 + c16 * 8;
#pragma unroll
    for (int i = 0; i < 4; ++i) r[i] = *(const v4u*)(ap + (size_t)(8 * i) * K);
#pragma unroll
    for (int i = 0; i < 8; ++i) r[4 + i] = *(const v4u*)(bp + (size_t)(8 * i) * K);
}
__device__ __forceinline__ void store_chunk(LAS unsigned char* lds, const v4u (&r)[12], const int tid) {
    const int row = tid >> 6, c16 = tid & 63;
#pragma unroll
    for (int i = 0; i < 4; ++i) *(LAS v4u*)(lds + A_OFF + (row + 8 * i) * CP + c16 * 16) = r[i];
#pragma unroll
    for (int i = 0; i < 8; ++i) *(LAS v4u*)(lds + B_OFF + (row + 8 * i) * CP + c16 * 16) = r[4 + i];
}
__device__ __forceinline__ void finish_tile(LAS unsigned char* lds, f32x4 (&acc)[2][2], const int ntn, const int it, const int kind, bf16* xb, float* ssq_w, const float pre_ssq, bf16* U,
                                            const int tid, const int c, const int g, const int sub, const int kq) {
    const int tm = it / ntn, tn = it % ntn;
    LAS float* red = (LAS float*)(lds + RED_OFF);
#pragma unroll
    for (int i = 0; i < 2; ++i)
#pragma unroll
        for (int j = 0; j < 2; ++j)
#pragma unroll
            for (int r = 0; r < 4; ++r) { red[(kq * 32 + 16 * i + 4 * g + r) * 64 + sub * 32 + 16 * j + c] = acc[i][j][r]; acc[i][j][r] = 0.f; }
    WG_BAR();
    const int row = tid >> 4, cq = tid & 15;
    f32x4 v = *(const LAS f32x4*)(red + row * 64 + 4 * cq);
#pragma unroll
    for (int q = 1; q < 4; ++q) v += *(const LAS f32x4*)(red + (q * 32 + row) * 64 + 4 * cq);
    const size_t grow = (size_t)NTP + tm * 32 + row; const int gcol = tn * 64 + 4 * cq;
    if (kind == 1) {
        float p = pre_ssq;
        p += __shfl_xor(p, 1); p += __shfl_xor(p, 2); p += __shfl_xor(p, 4); p += __shfl_xor(p, 8);
        const float rstd = __builtin_amdgcn_rsqf(p * (1.0f / 1024.0f) + EPS);
        f32x4 u;
#pragma unroll
        for (int e = 0; e < 4; ++e) { const float a = fmaxf(v[e] * rstd, 0.f); u[e] = a * a; }
        u32x2 w; w.x = pkb(u[0], u[1]); w.y = pkb(u[2], u[3]); *(u32x2*)(U + grow * FF + gcol) = w;
    } else {
        const u32x2 xo = *(const u32x2*)(xb + grow * D + gcol);
        const f32x4 x = (f32x4){__builtin_bit_cast(float, xo.x << 16), __builtin_bit_cast(float, xo.x & 0xffff0000u), __builtin_bit_cast(float, xo.y << 16), __builtin_bit_cast(float, xo.y & 0xffff0000u)} + v;
        u32x2 w; w.x = pkb(x[0], x[1]); w.y = pkb(x[2], x[3]); *(u32x2*)(xb + grow * D + gcol) = w;
        float ss = (x[0] * x[0] + x[1] * x[1]) + (x[2] * x[2] + x[3] * x[3]);
        ss += __shfl_xor(ss, 1); ss += __shfl_xor(ss, 2); ss += __shfl_xor(ss, 4); ss += __shfl_xor(ss, 8);
        if (cq == 0) ssq_w[grow * 16 + tn] = ss;
    }
    WG_BAR();
}
__device__ __forceinline__ void stream(LAS unsigned char* lds, const bf16* A, const bf16* Bt, const int K, const int ntn, const int first0, const int stride, const int nit, const int j0, const int j1, const int kind,
                                       bf16* xb, float* ssq_w, const float* ssq_r, bf16* U, const int tid) {
    const int lane = tid & 63, wave = __builtin_amdgcn_readfirstlane(tid >> 6), c = lane & 15, g = lane >> 4, sub = wave & 1, kq = wave >> 1;
    if (first0 >= nit) return;
    const int nch = K >> 9;
    const int nall = (nit - first0 + stride - 1) / stride;
    const int je = j1 < nall ? j1 : nall; if (j0 >= je) return;
    const int first = first0 + j0 * stride, Q = (je - j0) * nch;
    f32x4 acc[2][2];
#pragma unroll
    for (int i = 0; i < 2; ++i)
#pragma unroll
        for (int j = 0; j < 2; ++j) acc[i][j] = (f32x4){0.f, 0.f, 0.f, 0.f};
    v4u r[12];
    load_chunk(r, A, Bt, K, ntn, first, 0, tid);
    float pre = 0.f;
    const LAS unsigned char* ard = lds + A_OFF + c * CP + (kq * 128 + 8 * g) * 2;
    const LAS unsigned char* brd = lds + B_OFF + (sub * 32 + c) * CP + (kq * 128 + 8 * g) * 2;
    for (int q = 0; q < Q; ++q) {
        const int ti = q / nch, ch = q % nch, it = first + ti * stride;
        store_chunk(lds, r, tid);
        if (ch == 0 && kind == 1) pre = ssq_r[((size_t)NTP + (it / ntn) * 32 + (tid >> 4)) * 16 + (tid & 15)];
        WG_BAR();
        if (q + 1 < Q) { const int t1 = (q + 1) / nch; load_chunk(r, A, Bt, K, ntn, first + t1 * stride, (q + 1) % nch, tid); }
#pragma unroll
        for (int u = 0; u < 4; ++u) {
            const bf16x8 a0 = *(const LAS bf16x8*)(ard + 64 * u), a1 = *(const LAS bf16x8*)(ard + 16 * CP + 64 * u), b0 = *(const LAS bf16x8*)(brd + 64 * u), b1 = *(const LAS bf16x8*)(brd + 16 * CP + 64 * u);
            acc[0][0] = __builtin_amdgcn_mfma_f32_16x16x32_bf16(a0, b0, acc[0][0], 0, 0, 0); acc[0][1] = __builtin_amdgcn_mfma_f32_16x16x32_bf16(a0, b1, acc[0][1], 0, 0, 0);
            acc[1][0] = __builtin_amdgcn_mfma_f32_16x16x32_bf16(a1, b0, acc[1][0], 0, 0, 0); acc[1][1] = __builtin_amdgcn_mfma_f32_16x16x32_bf16(a1, b1, acc[1][1], 0, 0, 0);
        }
        WG_BAR();
        if (ch == nch - 1) finish_tile(lds, acc, ntn, it, kind, xb, ssq_w, pre, U, tid, c, g, sub, kq);
    }
}
}

__global__ void __launch_bounds__(NWAVES * 64, 2) mk_fwd(Args args) {
    extern __shared__ __attribute__((aligned(16))) unsigned char lds_raw[];
    LAS unsigned char* lds = (LAS unsigned char*)lds_raw;
    volatile LAS unsigned* MISC = (volatile LAS unsigned*)(lds + MISC_OFF);
    const int tid0 = threadIdx.x, wave = __builtin_amdgcn_readfirstlane(tid0 >> 6);
#define OLDS() ({ unsigned _b = (unsigned)(uintptr_t)lds; asm volatile("" : "+s"(_b)); (LAS unsigned char*)(uintptr_t)_b; })
#define FRESH_TID(name) int name; asm volatile("v_mbcnt_lo_u32_b32 %0, -1, 0\n\tv_mbcnt_hi_u32_b32 %0, -1, %0\n\tv_lshl_or_b32 %0, %1, 6, %0" : "=&v"(name) : "s"(wave))
    const int G = gridDim.x; const int bx = blockIdx.x; const int vcu = (G % 8 == 0) ? (bx % 8) * (G / 8) + bx / 8 : bx;
    unsigned char* ws = args.ws;
    gu32* ctl = (gu32*)(ws + WS_CTL);
    for (int u = tid0; u < (LDS_BYTES - LDSCTL_OFF) / 4; u += NWAVES * 64) ((LAS unsigned*)(lds + LDSCTL_OFF))[u] = 0u;
    __syncthreads();
    const int lo = args.ph_lo, hi = args.ph_hi;
    XcdBarrier bar; bar.bar = (unsigned*)(ctl + CW_BAR); bar.x = 0; bar.st = nullptr;
    bar = xcd_barrier_post((unsigned*)(ctl + CW_BAR), MISC + 8);
    XcdBarrier barS = xcd_barrier_post((unsigned*)(ctl + CW_BAR) + XCD_BAR_WORDS, MISC + 12);
#define IN(k) (lo <= (k) && (k) < hi)
#define SEAM(k) do { if (IN(k) && IN((k) + 1)) xcd_barrier(bar); } while (0)

    if (IN(0)) { FRESH_TID(tid_q); phase_prologue(args, OLDS(), vcu, G, wave, tid_q & 63, tid_q); if (IN(1)) xcd_arrive(bar); }

    for (int ph = (lo > 1 ? lo : 1); ph < (hi < 15 ? hi : 15); ++ph) {
        const int l = (ph - 1) / 7, k = (ph - 1) % 7;
        if (k == 1) {
            FRESH_TID(tid_a);
            const bf16* PRJ = (const bf16*)(ws + WS_PROJ); bf16* MX = (bf16*)(ws + WS_MIX); bf16* MXS = (bf16*)(ws + WS_MIXS) - (size_t)NTP * D;
            const float* st_in = args.in[4] + (size_t)l * 8388608; float* st_out = args.out + OFF_NSS + (size_t)l * 8388608; const float* onorm = args.in[9] + l * 128;
            for (int it = vcu; it < 256; it += G) hg::pass1_item(OLDS(), PRJ, (float*)(ws + WS_HG), (float*)(ws + WS_HG + 16 * MiB), it, tid_a);
            xcd_arrive(bar);
            att::run<5>(OLDS(), PRJ, args.in[2] + (size_t)l * 2097152, args.in[3] + (size_t)l * 2097152, args.in[7] + l * 8, MX, MXS, vcu, G, 768, tid_a);
            xcd_wait(bar);
            { FRESH_TID(tid_c);
              hg::combine_phase((float*)(ws + WS_HG), (const float*)(ws + WS_HG + 16 * MiB), args.out + OFF_NSP + (size_t)l * 262144, vcu * (NWAVES * 64) + tid_c, G * NWAVES * 64); }
            xcd_arrive(bar);
            { FRESH_TID(tid_s);
              f32x4 SA[8], SB[8]; v4u lwA[DS], qwA[DS], lwB[DS], qwB[DS]; hg::u32x2 vwA[DS], vwB[DS];
              for (int sa = vcu; sa < 512; sa += 2 * G) {
                  const int sb2 = sa + G;
                  hg::sample_load(PRJ, st_in, sa, tid_s, SA, lwA, qwA, vwA);
                  hg::sample_load(PRJ, st_in, sb2 < 512 ? sb2 : 511, tid_s, SB, lwB, qwB, vwB);
                  hg::sample_compute(OLDS(), PRJ, st_out, onorm, MXS, sa, tid_s, SA, lwA, qwA, vwA);
                  if (sb2 < 512) hg::sample_compute(OLDS(), PRJ, st_out, onorm, MXS, sb2, tid_s, SB, lwB, qwB, vwB);
              } }
            xcd_wait(bar);
            { FRESH_TID(tid_p);
              for (int it = vcu; it < 256; it += G) hg::pass2_item(OLDS(), PRJ, (const float*)(ws + WS_HG), onorm, MX, it, tid_p); }
            if (IN(ph + 2) && IN(ph + 3)) xcd_barrier(bar);
            continue;
        }
        if (k == 2 || k == 3) continue;
        bf16* XB = (bf16*)(ws + WS_XB); bf16* PROJ = (bf16*)(ws + WS_PROJ); bf16* MIXB = (bf16*)(ws + WS_MIX); bf16* UB = (bf16*)(ws + WS_U);
        pg8::Gemm g; pg8::EpiAny E{0, l, ws, args.out, args.in[0], args.in[1], WS_ROT, WS_LB, WS_SSQ, SSQ_STRIDE, WS_PROJ, WS_XB, WS_U, OFF_NKP, OFF_NVP, OFF_NKS, OFF_NVS};
        if (k == 0)      { g = pg8::Gemm{XB, (const bf16*)(ws + WS_WIN) + (size_t)l * INW * D, M, INW, D}; E.kind = 0; }
        else if (k == 4) { g = pg8::Gemm{MIXB, (const bf16*)(ws + WS_WO) + (size_t)l * D * D, NTP, D, D}; E.kind = 2; }
        else if (k == 5) { g = pg8::Gemm{XB, (const bf16*)(ws + WS_WUP) + (size_t)l * FF * D, NTP, FF, D}; E.kind = 1; }
        else             { g = pg8::Gemm{UB, (const bf16*)(ws + WS_WDN) + (size_t)l * D * FF, NTP, D, FF}; E.kind = 3; }
        pg8::StaticOrder S; S.init(g.M, g.N, G, bx);
        FRESH_TID(tid_o);
        const int ntn = g.N >> 6, nit = 16 * ntn, npre = (k == 5) ? (vcu & 3) : (k >= 4) ? (vcu & 1) : 0;
        float* ssq_w = (float*)(ws + WS_SSQ + (size_t)(2 * l + (k == 4 ? 1 : 2)) * SSQ_STRIDE);
        const float* ssq_r = (const float*)(ws + WS_SSQ + (size_t)(2 * l + 1) * SSQ_STRIDE);
        const int NGWf = G * NWAVES, f_lo = (l == 0) ? I_IN : PER_L + I_IN, f_hi = (l == 0) ? PER_L + I_IN : 2 * PER_L, f_n = (f_hi - f_lo + NGWf - 1) / NGWf, fgrp = vcu % 3;
        const int f_pre = (f_n * (fgrp + 1) + 2) / 3, c_pre = (l == 1) ? (fgrp + 1 < CACHE_ITERS ? fgrp + 1 : CACHE_ITERS) : 0, c_n = (l == 1) ? CACHE_ITERS : 0;
        if (k == 0) { const int lane_o = tid_o & 63;
            convert_weights(args, OLDS(), vcu * NWAVES + wave, NGWf, f_lo, f_hi, 0, f_pre, wave, lane_o);
            copy_caches(args, vcu * (NWAVES * 64) + tid_o, G * NWAVES * 64, 0, c_pre);
            if (IN(ph - 1)) { xcd_wait(bar); if (l > 0) xcd_wait(barS); } else __syncthreads(); }
        if (k >= 4 && npre > 0) { FRESH_TID(tid_s);
            if (k > 4) xcd_wait(barS);
            sg::stream(OLDS(), k == 4 ? (const bf16*)(ws + WS_MIXS) : g.A + (size_t)NTP * g.K, g.Bt, g.K, ntn, vcu, G, nit, 0, npre, k == 5 ? 1 : 2, XB, ssq_w, ssq_r, UB, tid_s); }
        if (k > 4) xcd_wait(bar);
        pg8::gemm_phase<pg8::EpiAny, pg8::StaticOrder, true, true>(OLDS(), g, S, E, tid_o);
        if (k == 0) {
            FRESH_TID(tid_f); const int lane_f = tid_f & 63;
            if (IN(ph + 1)) xcd_arrive(bar);
            convert_weights(args, OLDS(), vcu * NWAVES + wave, NGWf, f_lo, f_hi, f_pre, f_n, wave, lane_f);
            copy_caches(args, vcu * (NWAVES * 64) + tid_f, G * NWAVES * 64, c_pre, c_n);
            if (IN(ph + 1)) xcd_wait(bar);
            continue;
        }
        xcd_arrive(bar);
        { FRESH_TID(tid_s);
            if (k > 4 && npre == 0) xcd_wait(barS);
            sg::stream(OLDS(), k == 4 ? (const bf16*)(ws + WS_MIXS) : g.A + (size_t)NTP * g.K, g.Bt, g.K, ntn, vcu, G, nit, npre, 1 << 20, k == 5 ? 1 : 2, XB, ssq_w, ssq_r, UB, tid_s);
            xcd_arrive(barS); }
        if (k == 6 && l + 1 == DEPTH) { xcd_wait(bar); xcd_wait(barS); }
    }
    if (IN(15)) { FRESH_TID(tid_n); phase_final_norm(args, vcu, G, wave, tid_n & 63); }
#undef IN
#undef SEAM
}

extern "C" void kernel_launch(void* const* d_in, const int* in_sizes, int n_in, void* d_out, int out_size, void* d_ws, size_t ws_size, hipStream_t stream) {
    static int grid = 0;
    if (grid == 0) {
        if (n_in != 15 || in_sizes[0] != NTP * D || (size_t)out_size != OUT_TOTAL || ws_size < WS_END) {
            fprintf(stderr, "kernel_launch: unexpected shapes (n_in %d, in0 %d, out %d, ws %zu)\n", n_in, n_in > 0 ? in_sizes[0] : -1, out_size, ws_size); grid = -1; return; }
        int dev = 0, cus = 0, per_cu = 0;
        if (hipGetDevice(&dev) != hipSuccess || hipDeviceGetAttribute(&cus, hipDeviceAttributeMultiprocessorCount, dev) != hipSuccess) { grid = -1; return; }
        if (hipFuncSetAttribute((const void*)mk_fwd, hipFuncAttributeMaxDynamicSharedMemorySize, LDS_BYTES) != hipSuccess) { fprintf(stderr, "kernel_launch: hipFuncSetAttribute failed\n"); grid = -1; return; }
        if (hipOccupancyMaxActiveBlocksPerMultiprocessor(&per_cu, (const void*)mk_fwd, NWAVES * 64, LDS_BYTES) != hipSuccess || per_cu < 1) { fprintf(stderr, "kernel_launch: occupancy query says %d\n", per_cu); }
        (void)hipGetLastError();
        grid = cus;
    }
    if (grid < 0) return;
    (void)hipMemsetAsync((char*)d_ws + WS_CTL, 0, CTL_ZERO_BYTES, stream);
    Args a{};
    for (int i = 0; i < 15; ++i) a.in[i] = (const float*)d_in[i];
    a.out = (float*)d_out; a.ws = (unsigned char*)d_ws;
    for (int j = 0; j < 8; ++j) a.invf[j] = pow(500000.0, -(double)j / 8.0);
    auto run = [&](int lo, int hi) { a.ph_lo = lo; a.ph_hi = hi; hipLaunchKernelGGL(mk_fwd, dim3(grid), dim3(NWAVES * 64), LDS_BYTES, stream, a); };
#ifdef PROBE_PREFIX
    run(0, PROBE_PREFIX);
    (void)hipMemsetAsync((char*)d_ws + WS_CTL, 0, CTL_ZERO_BYTES, stream);
#endif
    run(0, 16);
}
```

```cpp
#include <hip/hip_runtime.h>
#include <cstdio>
#include <cstdint>
#include <cmath>

namespace pg8 {
#define PG8_LAS __attribute__((address_space(3)))
typedef unsigned short bf16_t;
typedef short bf16x8 __attribute__((ext_vector_type(8)));
typedef float f32x4 __attribute__((ext_vector_type(4)));
typedef unsigned u32x4 __attribute__((ext_vector_type(4)));
typedef unsigned u32x2 __attribute__((ext_vector_type(2)));
constexpr int BM = 256, BK = 64, HALF = 128, HTB = HALF * BK * 2, STAGE_BYTES = 8 * HTB, NXCD = 8, WGM = 4;

__host__ __device__ __forceinline__ int lds_byte(int r, int c) { const int st = (r >> 4) * 2 + (c >> 5), rr = r & 15, cc = c & 31, ob = rr * 64 + cc * 2; return st * 1024 + (ob ^ (((ob >> 9) & 1) << 5)); }
__host__ __device__ __forceinline__ void stage_rc(int b, int& R, int& C) { const int st = b / 1024, sb = b % 1024, swz = sb ^ (((sb >> 9) & 1) << 5); R = (st >> 1) * 16 + swz / 64; C = (st & 1) * 32 + (swz % 64) / 2; }
__host__ __device__ __forceinline__ int perm32(int rho) { const int n = rho >> 4, i = rho & 15; return 8 * (i >> 2) + 4 * n + (i & 3); }

struct Unit { int pm, pn; };
struct Gemm { const bf16_t* A; const bf16_t* Bt; int M, N, K; };

struct StaticOrder {
    int nM, nN, nwg, G, c, nMm, nwgm;
    __host__ __device__ void init(int M, int N, int G_, int c_) { nM = M / BM; nN = N / BM; nwg = nM * nN; G = G_; c = c_; nMm = nM & ~7; nwgm = nMm * nN; }
    __host__ __device__ bool next(int i, Unit& u) const {
        const long L = (long)i * G + c; if (L >= nwg) return false;
        if (L >= nwgm) { const int s = (int)L - nwgm; u.pm = nMm + s / nN; u.pn = s % nN; return true; }
        int wgid = (int)L; { const int q = nwgm / NXCD, r = nwgm % NXCD, xcd = wgid % NXCD, off = wgid / NXCD; wgid = (xcd < r ? xcd * (q + 1) : r * (q + 1) + (xcd - r) * q) + off; }
        const int nig = WGM * nN, gid = wgid / nig, fm = gid * WGM, gsz = (nMm - fm) < WGM ? (nMm - fm) : WGM;
        u.pm = fm + ((wgid % nig) % gsz); u.pn = (wgid % nig) / gsz; return true;
    }
    __device__ __forceinline__ void a_ready(const Unit&) const {}
    __device__ __forceinline__ void done(const Unit&) const {}
};

__device__ __forceinline__ unsigned cvt_pk_bf16(float lo, float hi) { unsigned r; asm volatile("v_cvt_pk_bf16_f32 %0, %1, %2" : "=v"(r) : "v"(lo), "v"(hi)); return r; }

constexpr int NTOK_P = 16384, PW = 2816;
constexpr float RMS_EPS = 1e-6f;
constexpr float QSCALE = 0.125f * 1.4426950408889634f;

__device__ __forceinline__ void row_rstd8(const float* ssq, int row0, int fq, float (&rs)[8]) {
    f32x4 p[8];
#pragma unroll
    for (int i = 0; i < 8; ++i) p[i] = *(const f32x4*)(ssq + (size_t)(row0 + (i >> 2) * HALF + (i & 3) * 16) * 16 + 4 * fq);
#pragma unroll
    for (int i = 0; i < 8; ++i) { float s = (p[i][0] + p[i][1]) + (p[i][2] + p[i][3]); s += __shfl_xor(s, 16); s += __shfl_xor(s, 32); rs[i] = __builtin_amdgcn_rsqf(s * (1.0f / 1024.0f) + RMS_EPS); }
}

struct EpiIn {
    static constexpr bool PERM = true, AFTER_DRAIN = false;
    __device__ __forceinline__ bool perm() const { return true; }
    bf16_t* P; const float* ssq; const float* rot; const float* lb;
    float* nk_p; float* nv_p; float* nk_s; float* nv_s;
    __device__ __forceinline__ void row_part(const f32x4& a00, const f32x4& a01, const f32x4& a10, const f32x4& a11, int row, int pn, int type, bool rotw, int colw, int fq, const float r) const {
        f32x4 cs[4];
        if (rotw) { const int pidx = row < NTOK_P ? (row & 4095) : 4096 + ((row - NTOK_P) & 3);
#pragma unroll
            for (int i = 0; i < 4; ++i) cs[i] = *(const f32x4*)(rot + (size_t)pidx * 16 + 4 * i); }
#pragma unroll
        for (int bj = 0; bj < 2; ++bj) {
            float v[8];
#pragma unroll
            for (int e = 0; e < 4; ++e) { v[e] = (bj == 0 ? a00[e] : a10[e]) * r; v[4 + e] = (bj == 0 ? a01[e] : a11[e]) * r; }
            const int col = pn * BM + bj * HALF + colw;
            if (type == 0 || (type == 1 && bj == 0)) {
                if (rotw) {
#pragma unroll
                    for (int e = 0; e < 8; ++e) { const float pr = __shfl_xor(v[e], 16); const float c = cs[e >> 1][(e & 1) * 2], s = cs[e >> 1][(e & 1) * 2 + 1];
                        const float rr = (fq == 0) ? (v[e] * c - pr * s) : (v[e] * c + pr * s); v[e] = (fq < 2) ? rr : v[e]; }
                }
                if (type == 0) {
#pragma unroll
                    for (int e = 0; e < 8; ++e) v[e] *= QSCALE;
                }
            } else if (type == 2) {
#pragma unroll
                for (int e = 0; e < 8; ++e) v[e] = v[e] * __builtin_amdgcn_rcpf(1.0f + __builtin_amdgcn_exp2f(-1.4426950408889634f * v[e]));
            } else if (type == 3) {
                const f32x4 l0 = *(const f32x4*)(lb + (col - 1280)), l1 = *(const f32x4*)(lb + (col - 1280) + 4);
#pragma unroll
                for (int e = 0; e < 8; ++e) { const float lbv = e < 4 ? l0[e & 3] : l1[e & 3]; const float z = fmaxf(v[e], -80.f);
                    const float sg = __builtin_amdgcn_rcpf(1.0f + __builtin_amdgcn_exp2f(-1.4426950408889634f * z));
                    v[e] = __builtin_amdgcn_logf(lbv + (1.0f - lbv) * sg); }
            }
            u32x4 w; w.x = cvt_pk_bf16(v[0], v[1]); w.y = cvt_pk_bf16(v[2], v[3]); w.z = cvt_pk_bf16(v[4], v[5]); w.w = cvt_pk_bf16(v[6], v[7]);
            *(u32x4*)(P + (size_t)row * PW + col) = w;
            if (type == 1) {
                bool inc; float* dst;
                if (row < NTOK_P) { const int t = row & 4095, b = row >> 12; inc = t >= 3968; dst = (bj == 0 ? nk_p : nv_p) + ((size_t)(b * 128 + (t - 3968)) * 128 + colw); }
                else { const int r2 = row - NTOK_P, sb = r2 >> 2, i = r2 & 3; inc = true; dst = (bj == 0 ? nk_s : nv_s) + ((size_t)(sb * 128 + 124 + i) * 128 + colw); }
                if (inc) { *(f32x4*)dst = (f32x4){v[0], v[1], v[2], v[3]}; *(f32x4*)(dst + 4) = (f32x4){v[4], v[5], v[6], v[7]}; }
            }
        }
        asm volatile("" ::: "memory");
    }
    __device__ __forceinline__ void operator()(const f32x4 (&acc)[2][2][4][2], const Unit& u, int wr, int wc, int fr, int fq) const {
        const int pn = u.pn, row0 = u.pm * BM + wr * 64 + fr, colw = wc * 32 + 8 * fq;
        int type;
        if (pn < 2) type = 0; else if (pn == 2) type = 1; else if (pn < 5) type = 2; else if (pn < 7) type = 3; else if (pn < 9) type = 4; else type = 2;
        const bool rotw = ((wc & 1) == 0) && (type <= 1);
        float rs[8]; row_rstd8(ssq, row0, fq, rs);
#define EPIIN_ROW(ai, m) row_part(acc[ai][0][m][0], acc[ai][0][m][1], acc[ai][1][m][0], acc[ai][1][m][1], row0 + (ai) * HALF + (m) * 16, pn, type, rotw, colw, fq, rs[(ai) * 4 + (m)])
        EPIIN_ROW(0, 0); EPIIN_ROW(0, 1); EPIIN_ROW(0, 2); EPIIN_ROW(0, 3); EPIIN_ROW(1, 0); EPIIN_ROW(1, 1); EPIIN_ROW(1, 2); EPIIN_ROW(1, 3);
#undef EPIIN_ROW
    }
};
struct EpiUp {
    static constexpr bool PERM = true, AFTER_DRAIN = false;
    __device__ __forceinline__ bool perm() const { return true; }
    bf16_t* O; int ldc; const float* ssq;
    __device__ __forceinline__ void operator()(const f32x4 (&acc)[2][2][4][2], const Unit& u, int wr, int wc, int fr, int fq) const {
        const int row0 = u.pm * BM + wr * 64 + fr, col0 = u.pn * BM + wc * 32 + 8 * fq;
        float rs[8]; row_rstd8(ssq, row0, fq, rs);
#pragma unroll
        for (int ai = 0; ai < 2; ++ai)
#pragma unroll
            for (int m = 0; m < 4; ++m) { bf16_t* rowp = O + (size_t)(row0 + ai * HALF + m * 16) * ldc + col0; const float r = rs[ai * 4 + m];
#pragma unroll
                for (int bj = 0; bj < 2; ++bj) { f32x4 v0 = acc[ai][bj][m][0] * r, v1 = acc[ai][bj][m][1] * r;
#pragma unroll
                    for (int e = 0; e < 4; ++e) { const float a = fmaxf(v0[e], 0.f), b = fmaxf(v1[e], 0.f); v0[e] = a * a; v1[e] = b * b; }
                    u32x4 w; w.x = cvt_pk_bf16(v0[0], v0[1]); w.y = cvt_pk_bf16(v0[2], v0[3]); w.z = cvt_pk_bf16(v1[0], v1[1]); w.w = cvt_pk_bf16(v1[2], v1[3]);
                    *(u32x4*)(rowp + bj * HALF) = w; } }
    }
};
struct EpiRes {
    static constexpr bool PERM = true, AFTER_DRAIN = false;
    __device__ __forceinline__ bool perm() const { return true; }
    bf16_t* xb; float* ssq;
    __device__ __forceinline__ void init(f32x4 (&acc)[2][2][4][2], const Unit& u, int wr, int wc, int fr, int fq) const {
        const int row0 = u.pm * BM + wr * 64 + fr, col0 = u.pn * BM + wc * 32 + 8 * fq;
#pragma unroll
        for (int ai = 0; ai < 2; ++ai)
#pragma unroll
            for (int m = 0; m < 4; ++m)
#pragma unroll
                for (int bj = 0; bj < 2; ++bj) { const u32x4 w = *(const u32x4*)(xb + (size_t)(row0 + ai * HALF + m * 16) * 1024 + col0 + bj * HALF);
                    acc[ai][bj][m][0] = (f32x4){__builtin_bit_cast(float, w.x << 16), __builtin_bit_cast(float, w.x & 0xffff0000u), __builtin_bit_cast(float, w.y << 16), __builtin_bit_cast(float, w.y & 0xffff0000u)};
                    acc[ai][bj][m][1] = (f32x4){__builtin_bit_cast(float, w.z << 16), __builtin_bit_cast(float, w.z & 0xffff0000u), __builtin_bit_cast(float, w.w << 16), __builtin_bit_cast(float, w.w & 0xffff0000u)}; }
    }
    __device__ __forceinline__ void operator()(const f32x4 (&acc)[2][2][4][2], const Unit& u, int wr, int wc, int fr, int fq) const {
        const int row0 = u.pm * BM + wr * 64 + fr, col0 = u.pn * BM + wc * 32 + 8 * fq;
#pragma unroll
        for (int ai = 0; ai < 2; ++ai)
#pragma unroll
            for (int m = 0; m < 4; ++m) {
                const int row = row0 + ai * HALF + m * 16; float ss = 0.f;
#pragma unroll
                for (int bj = 0; bj < 2; ++bj) {
                    const f32x4 x0 = acc[ai][bj][m][0], x1 = acc[ai][bj][m][1];
                    ss += ((x0[0] * x0[0] + x0[1] * x0[1]) + (x0[2] * x0[2] + x0[3] * x0[3])) + ((x1[0] * x1[0] + x1[1] * x1[1]) + (x1[2] * x1[2] + x1[3] * x1[3]));
                    u32x4 w; w.x = cvt_pk_bf16(x0[0], x0[1]); w.y = cvt_pk_bf16(x0[2], x0[3]); w.z = cvt_pk_bf16(x1[0], x1[1]); w.w = cvt_pk_bf16(x1[2], x1[3]);
                    *(u32x4*)(xb + (size_t)row * 1024 + col0 + bj * HALF) = w;
                }
                ss += __shfl_xor(ss, 16); ss += __shfl_xor(ss, 32);
                if (fq == 0) ssq[(size_t)row * 16 + u.pn * 4 + wc] = ss;
            }
    }
};
struct EpiAny {
    static constexpr bool AFTER_DRAIN = false;
    int kind, l;
    unsigned char* ws; float* out; const float* x_p; const float* x_s;
    size_t o_rot, o_lb, o_ssq, ssq_stride, o_proj, o_xb, o_u;
    size_t f_nkp, f_nvp, f_nks, f_nvs;
    __device__ __forceinline__ bool perm() const { return true; }
    __device__ __forceinline__ void init(f32x4 (&acc)[2][2][4][2], const Unit& u, int wr, int wc, int fr, int fq) const {
        if (kind >= 2) { EpiRes E{(bf16_t*)(ws + o_xb), nullptr}; E.init(acc, u, wr, wc, fr, fq); }
        else {
#pragma unroll
            for (int a = 0; a < 2; ++a)
#pragma unroll
                for (int b = 0; b < 2; ++b)
#pragma unroll
                    for (int m = 0; m < 4; ++m)
#pragma unroll
                        for (int n = 0; n < 2; ++n) acc[a][b][m][n] = (f32x4){0.f, 0.f, 0.f, 0.f};
        }
    }
    __device__ __forceinline__ void operator()(const f32x4 (&acc)[2][2][4][2], const Unit& u, int wr, int wc, int fr, int fq) const {
        if (kind == 0) { EpiIn E{(bf16_t*)(ws + o_proj), (const float*)(ws + o_ssq + (size_t)(2 * l) * ssq_stride), (const float*)(ws + o_rot), (const float*)(ws + o_lb) + l * 512,
                                 out + f_nkp + (size_t)l * 65536, out + f_nvp + (size_t)l * 65536, out + f_nks + (size_t)l * 2097152, out + f_nvs + (size_t)l * 2097152}; E(acc, u, wr, wc, fr, fq); }
        else if (kind == 1) { EpiUp E{(bf16_t*)(ws + o_u), 4096, (const float*)(ws + o_ssq + (size_t)(2 * l + 1) * ssq_stride)}; E(acc, u, wr, wc, fr, fq); }
        else { EpiRes E{(bf16_t*)(ws + o_xb), (float*)(ws + o_ssq + (size_t)(2 * l + (kind == 2 ? 1 : 2)) * ssq_stride)}; E(acc, u, wr, wc, fr, fq); }
    }
};

template <class Epi, class Sched, bool ALIGN_EPI = false, bool SP2 = false>
__device__ __forceinline__ void gemm_phase(PG8_LAS unsigned char* lds, const Gemm g, const Sched& S, const Epi& E, const int tid) {
    const int wid = __builtin_amdgcn_readfirstlane(tid >> 6), lane = tid & 63, wr = wid >> 2, wc = wid & 3, fr = lane & 15, fq = lane >> 4;
    const int K = g.K, nt = K / BK;
    unsigned voffA[2], voffB[2];
#pragma unroll
    for (int i = 0; i < 2; ++i) { int R, C; stage_rc(tid * 16 + i * 8192, R, C); const int Rb = E.perm() ? ((R & ~31) + perm32(R & 31)) : R;
        voffA[i] = (unsigned)(R * K + C) * 2u; voffB[i] = (unsigned)(Rb * K + C) * 2u; }
    const size_t kstep = (size_t)(BK * 2);
    const size_t hstep = (size_t)HALF * K * 2;
    const size_t tstep = 2 * hstep;
    const unsigned ldsw = (unsigned)wid * 1024u;
    const int aoff = lds_byte(wr * 64 + fr, fq * 8), boff = lds_byte(wc * 32 + fr, fq * 8);
#define PG8_SA(b, h) (((b) * 2 + (h)) * HTB)
#define PG8_SB(b, h) ((4 + (b) * 2 + (h)) * HTB)
#define PG8_STAGE(bufoff, gbase, voff) do { _Pragma("unroll") for (int _i = 0; _i < 2; ++_i) \
        __builtin_amdgcn_global_load_lds((const unsigned*)((const char*)(gbase) + (voff)[_i]), (PG8_LAS unsigned*)(lds + (bufoff) + ldsw + _i * 8192), 16, 0, 0); } while (0)
#define PG8_LDA(dst, b, h) do { _Pragma("unroll") for (int m = 0; m < 4; ++m) _Pragma("unroll") for (int k = 0; k < 2; ++k) dst[m][k] = *(const PG8_LAS bf16x8*)(lds + PG8_SA(b, h) + aoff + m * 2048 + k * 1024); } while (0)
#define PG8_LDB(dst, b, h) do { _Pragma("unroll") for (int n = 0; n < 2; ++n) _Pragma("unroll") for (int k = 0; k < 2; ++k) dst[n][k] = *(const PG8_LAS bf16x8*)(lds + PG8_SB(b, h) + boff + n * 2048 + k * 1024); } while (0)
#define PG8_MMA(ai, bj, At, Bt) do { __builtin_amdgcn_s_setprio(1); _Pragma("unroll") for (int m = 0; m < 4; ++m) _Pragma("unroll") for (int n = 0; n < 2; ++n) _Pragma("unroll") for (int k = 0; k < 2; ++k) \
        acc[ai][bj][m][n] = __builtin_amdgcn_mfma_f32_16x16x32_bf16(Bt[n][k], At[m][k], acc[ai][bj][m][n], 0, 0, 0); __builtin_amdgcn_s_setprio(0); } while (0)
#define PG8_WAIT_V(n) asm volatile("s_waitcnt vmcnt(" #n ")" ::: "memory")
#define PG8_WAIT_L(n) asm volatile("s_waitcnt lgkmcnt(" #n ")" ::: "memory")
#define PG8_BAR __builtin_amdgcn_s_barrier()
#define PG8_SCHED __builtin_amdgcn_sched_barrier(0)
    Unit cur, nxt; int ui = 0;
    if (!S.next(0, cur)) return;
    f32x4 acc[2][2][4][2];
    bf16x8 At[4][2], B0[2][2], B1[2][2];
    const char* cA = (const char*)g.A + (size_t)cur.pm * tstep; const char* cB = (const char*)g.Bt + (size_t)cur.pn * tstep;
    S.a_ready(cur);
    E.init(acc, cur, wr, wc, fr, fq);
    if constexpr (SP2) {
        PG8_STAGE(PG8_SB(0, 0), cB, voffB); PG8_STAGE(PG8_SB(0, 1), cB + hstep, voffB); PG8_STAGE(PG8_SA(0, 0), cA, voffA); PG8_STAGE(PG8_SA(0, 1), cA + hstep, voffA);
        if (wr == 1) PG8_BAR;
        PG8_WAIT_V(2); PG8_BAR;
        PG8_STAGE(PG8_SB(1, 0), cB + kstep, voffB); PG8_STAGE(PG8_SA(1, 0), cA + kstep, voffA); PG8_STAGE(PG8_SB(1, 1), cB + hstep + kstep, voffB);
        PG8_WAIT_V(6); PG8_BAR;
    } else {
        PG8_STAGE(PG8_SB(0, 0), cB, voffB); PG8_STAGE(PG8_SA(0, 0), cA, voffA); PG8_STAGE(PG8_SB(0, 1), cB + hstep, voffB); PG8_STAGE(PG8_SA(0, 1), cA + hstep, voffA);
        if (wr == 1) PG8_BAR;
        PG8_WAIT_V(4); PG8_BAR;
        PG8_STAGE(PG8_SB(1, 0), cB + kstep, voffB); PG8_STAGE(PG8_SA(1, 0), cA + kstep, voffA); PG8_STAGE(PG8_SB(1, 1), cB + hstep + kstep, voffB);
        PG8_WAIT_V(6); PG8_BAR;
    }
#pragma unroll
    for (int a = 0; a < 2; ++a)
#pragma unroll
        for (int b = 0; b < 2; ++b)
#pragma unroll
            for (int m = 0; m < 4; ++m) asm volatile("" : "+v"(acc[a][b][m][0]), "+v"(acc[a][b][m][1]));
    for (;;) {
        const bool has_next = S.next(ui + 1, nxt);
        const char* nA = has_next ? (const char*)g.A + (size_t)nxt.pm * tstep : cA; const char* nB = has_next ? (const char*)g.Bt + (size_t)nxt.pn * tstep : cB;
        for (int t = 0; t < nt; t += 2) {
            const bool last = (t == nt - 2);
            const char* a1 = cA + (size_t)(t + 1) * kstep;
            const char* a2 = last ? nA : cA + (size_t)(t + 2) * kstep; const char* b2 = last ? nB : cB + (size_t)(t + 2) * kstep;
            const char* a3 = a2 + kstep; const char* b3 = b2 + kstep;
            if (last && has_next) S.a_ready(nxt);
            if constexpr (SP2) {
            PG8_LDB(B0, 0, 0); PG8_LDB(B1, 0, 1); PG8_SCHED; PG8_LDA(At, 0, 0); PG8_STAGE(PG8_SA(1, 1), a1 + hstep, voffA);
            PG8_WAIT_V(8); PG8_WAIT_L(0); PG8_BAR; PG8_MMA(0, 0, At, B0); PG8_MMA(0, 1, At, B1); PG8_BAR; PG8_SCHED;
            PG8_LDA(At, 0, 1); PG8_STAGE(PG8_SB(0, 0), b2, voffB); PG8_STAGE(PG8_SB(0, 1), b2 + hstep, voffB); PG8_STAGE(PG8_SA(0, 0), a2, voffA);
            PG8_WAIT_V(8); PG8_WAIT_L(0); PG8_BAR; PG8_MMA(1, 0, At, B0); PG8_MMA(1, 1, At, B1); PG8_BAR; PG8_SCHED;
            PG8_LDB(B0, 1, 0); PG8_LDB(B1, 1, 1); PG8_SCHED; PG8_LDA(At, 1, 0); PG8_STAGE(PG8_SA(0, 1), a2 + hstep, voffA);
            PG8_WAIT_V(8); PG8_WAIT_L(0); PG8_BAR; PG8_MMA(0, 0, At, B0); PG8_MMA(0, 1, At, B1); PG8_BAR; PG8_SCHED;
            PG8_LDA(At, 1, 1); PG8_STAGE(PG8_SB(1, 0), b3, voffB); PG8_STAGE(PG8_SB(1, 1), b3 + hstep, voffB); PG8_STAGE(PG8_SA(1, 0), a3, voffA);
            PG8_WAIT_V(8); PG8_WAIT_L(0); PG8_BAR; PG8_MMA(1, 0, At, B0); PG8_MMA(1, 1, At, B1); PG8_BAR; PG8_SCHED;
            } else {
            PG8_LDB(B0, 0, 0); PG8_SCHED; PG8_LDA(At, 0, 0); PG8_STAGE(PG8_SA(1, 1), a1 + hstep, voffA);
            PG8_WAIT_L(8); PG8_BAR; PG8_WAIT_L(0); PG8_MMA(0, 0, At, B0); PG8_BAR; PG8_SCHED;
            PG8_LDB(B1, 0, 1); PG8_STAGE(PG8_SB(0, 0), b2, voffB);
            PG8_BAR; PG8_WAIT_L(0); PG8_MMA(0, 1, At, B1); PG8_BAR;
            PG8_LDA(At, 0, 1); PG8_STAGE(PG8_SA(0, 0), a2, voffA);
            PG8_BAR; PG8_WAIT_L(0); PG8_MMA(1, 0, At, B0); PG8_BAR; PG8_SCHED;
            PG8_STAGE(PG8_SB(0, 1), b2 + hstep, voffB);
            PG8_WAIT_V(6); PG8_BAR; PG8_MMA(1, 1, At, B1); PG8_BAR;
            PG8_LDB(B0, 1, 0); PG8_SCHED; PG8_LDA(At, 1, 0); PG8_STAGE(PG8_SA(0, 1), a2 + hstep, voffA);
            PG8_WAIT_L(8); PG8_BAR; PG8_WAIT_L(0); PG8_MMA(0, 0, At, B0); PG8_BAR; PG8_SCHED;
            PG8_LDB(B1, 1, 1); PG8_STAGE(PG8_SB(1, 0), b3, voffB);
            PG8_BAR; PG8_WAIT_L(0); PG8_MMA(0, 1, At, B1); PG8_BAR;
            PG8_LDA(At, 1, 1); PG8_STAGE(PG8_SA(1, 0), a3, voffA);
            PG8_BAR; PG8_WAIT_L(0); PG8_MMA(1, 0, At, B0); PG8_BAR; PG8_SCHED;
            PG8_STAGE(PG8_SB(1, 1), b3 + hstep, voffB);
            PG8_WAIT_V(6); PG8_BAR; PG8_MMA(1, 1, At, B1); PG8_BAR;
            }
        }
        if constexpr (ALIGN_EPI) { if (wr == 0) PG8_BAR; }
        if constexpr (!Epi::AFTER_DRAIN) { E(acc, cur, wr, wc, fr, fq); S.done(cur); }
        if (!has_next) break;
        E.init(acc, nxt, wr, wc, fr, fq);
        cur = nxt; cA = nA; cB = nB; ++ui;
        if constexpr (ALIGN_EPI) { if (wr == 1) PG8_BAR; }
    }
    PG8_WAIT_V(0);
    if constexpr (!ALIGN_EPI) { if (wr == 0) PG8_BAR; }
    PG8_BAR;
#undef PG8_SA
#undef PG8_SB
#undef PG8_STAGE
#undef PG8_LDA
#undef PG8_LDB
#undef PG8_MMA
#undef PG8_WAIT_V
#undef PG8_WAIT_L
#undef PG8_BAR
#undef PG8_SCHED
}
}

constexpr int NWAVES = 8;
#ifndef REP_PRO
#define REP_PRO 1
#endif
#ifndef REP_ATT
#define REP_ATT 1
#endif
#ifndef REP_P1
#define REP_P1 1
#endif
#ifndef REP_P2
#define REP_P2 1
#endif
#ifndef REP_SMP
#define REP_SMP 1
#endif
#ifndef REP_GIN
#define REP_GIN 1
#endif
#ifndef REP_GUP
#define REP_GUP 1
#endif
#ifndef REP_SG
#define REP_SG 1
#endif
constexpr int D = 1024, SEQ = 4096, NB = 4, NTP = NB * SEQ, DB = 128, DS = 4, NTS = DB * DS, M = NTP + NTS;
constexpr int DEPTH = 2, PASTLEN = 16384, WIN = 128;
constexpr int INW = 2816, FF = 4096;
constexpr int C_QA = 0, C_KA = 512, C_VA = 640, C_QH = 768, C_FH = 1280, C_IH = 1792, C_GH = 2304;
constexpr float EPS = 1e-6f;
constexpr float LOG2E = 1.4426950408889634f;
constexpr int NPOS = 4100;
constexpr size_t OFF_Y = 0, OFF_NKP = (size_t)M * D, OFF_NVP = OFF_NKP + 131072, OFF_NSP = OFF_NVP + 131072, OFF_NKS = OFF_NSP + 524288,
                 OFF_NVS = OFF_NKS + 4194304, OFF_NSS = OFF_NVS + 4194304, OUT_TOTAL = OFF_NSS + 16777216;
constexpr size_t MiB = 1u << 20;
constexpr size_t WS_CTL = 0, CTL_ZERO_BYTES = 64 * 1024;
constexpr size_t WS_ROT = 1 * MiB;
constexpr size_t WS_LB = 1 * MiB + 512 * 1024;
constexpr size_t WS_SSQ = 2 * MiB, SSQ_STRIDE = 1310720;
constexpr size_t WS_WIN = 10 * MiB, WS_WO = 21 * MiB, WS_WUP = 25 * MiB, WS_WDN = 41 * MiB;
constexpr size_t WS_XB = 57 * MiB;
constexpr size_t WS_HG = 90 * MiB;
constexpr size_t WS_BIG = 107 * MiB;
constexpr size_t WS_PROJ = WS_BIG, WS_MIX = 198 * MiB, WS_U = WS_BIG, WS_MIXS = 239 * MiB, WS_END = 240 * MiB;
static_assert(WS_SSQ + 5 * SSQ_STRIDE <= WS_WIN && WS_PROJ + (size_t)M * INW * 2 <= WS_MIX && WS_MIX + (size_t)M * D * 2 <= WS_MIXS && WS_U + (size_t)M * FF * 2 <= WS_MIXS && WS_MIXS + (size_t)NTS * D * 2 <= WS_END, "ws map");
static_assert(WS_WIN + (size_t)DEPTH * INW * D * 2 <= WS_WO && WS_XB + (size_t)M * D * 2 <= WS_HG, "ws map 2");

constexpr int RING_OFF = 0, RING_BYTES = 131072, LDSCTL_OFF = RING_BYTES, MISC_OFF = LDSCTL_OFF + 320, LDS_BYTES = 147456;

#define GAS __attribute__((address_space(1)))
#define LAS __attribute__((address_space(3)))
typedef unsigned short bf16;
typedef unsigned v4u __attribute__((ext_vector_type(4)));
typedef float f32x4 __attribute__((ext_vector_type(4)));
typedef GAS unsigned gu32;
#define RLX_AGENT __ATOMIC_RELAXED, __HIP_MEMORY_SCOPE_AGENT
#define LDS_WAIT() asm volatile("s_waitcnt lgkmcnt(0)" ::: "memory")
#define WG_BAR() do { asm volatile("s_waitcnt lgkmcnt(0)" ::: "memory"); __builtin_amdgcn_s_barrier(); asm volatile("" ::: "memory"); } while (0)
__device__ __forceinline__ unsigned f2bf(float f) { unsigned u = __builtin_bit_cast(unsigned, f); return (u + 0x7fffu + ((u >> 16) & 1u)) >> 16; }
__device__ __forceinline__ unsigned pk2(float lo, float hi) { return f2bf(lo) | (f2bf(hi) << 16); }
__device__ __forceinline__ unsigned pkb(float lo, float hi) { return pg8::cvt_pk_bf16(lo, hi); }
__device__ __forceinline__ unsigned pkb1(float v) { return pg8::cvt_pk_bf16(v, v); }
__device__ __forceinline__ float bf2f(bf16 v) { return __builtin_bit_cast(float, (unsigned)v << 16); }
__device__ __forceinline__ float wave_sum(float v) {
#pragma unroll
    for (int o = 1; o < 64; o <<= 1) v += __shfl_xor(v, o);
    return v;
}
__device__ __forceinline__ float wave_max(float v) {
#pragma unroll
    for (int o = 1; o < 64; o <<= 1) v = fmaxf(v, __shfl_xor(v, o));
    return v;
}

#define XB_TMO      128
#define XB_XCNT(j)  (256  + 64 * (j))
#define XB_XSUB(j)  (1280 + 64 * (j))
#define XB_XGEN(j)  (2304 + 64 * (j))
#define XB_TOP      3328
#define XB_TOPGEN   3392
#define XCD_BAR_WORDS 3456
#define XB_SPIN_CAP (1u << 18)
__device__ __forceinline__ unsigned xb_ld(unsigned* p)              { return __hip_atomic_load(p, __ATOMIC_RELAXED, __HIP_MEMORY_SCOPE_AGENT); }
__device__ __forceinline__ unsigned xb_add(unsigned* p, unsigned v) { return __hip_atomic_fetch_add(p, v, __ATOMIC_RELAXED, __HIP_MEMORY_SCOPE_AGENT); }
__device__ __forceinline__ unsigned xb_xcc_id() { return (unsigned)__builtin_amdgcn_s_getreg((3 << 11) | 20) & 0xFu; }
#define XB_SPIN(cond, bar) do { unsigned _sp = 0; while (cond) { __builtin_amdgcn_s_sleep(1); \
    if ((++_sp & 255u) == 0u) { if (xb_ld(&(bar)[XB_TMO])) break; if (_sp > XB_SPIN_CAP) { atomicAdd(&(bar)[XB_TMO], 1u); break; } } } } while (0)
struct XcdBarrier { unsigned* bar; unsigned x; volatile LAS unsigned* st; };
__device__ __forceinline__ XcdBarrier xcd_barrier_post(unsigned* bar, volatile LAS unsigned* st) {
    XcdBarrier b; b.bar = bar; b.x = xb_xcc_id(); b.st = st;
    if (threadIdx.x == 0) (void)xb_add(&bar[XB_XCNT(b.x)], 1u);
    return b;
}
__device__ __forceinline__ void xcd_barrier_complete(unsigned* bar, unsigned x, unsigned& nloc, unsigned& nx) {
    const unsigned G = gridDim.x * gridDim.y * gridDim.z;
    unsigned sum, cnt, mine, sp = 0u;
    for (;;) {
        sum = 0u; cnt = 0u; mine = 0u;
#pragma unroll
        for (unsigned j = 0; j < 16; ++j) { const unsigned c = xb_ld(&bar[XB_XCNT(j)]); sum += c; cnt += (c > 0u) ? 1u : 0u; mine = (j == x) ? c : mine; }
        if (sum == G) break;
        __builtin_amdgcn_s_sleep(1);
        if ((++sp & 255u) == 0u) { if (xb_ld(&bar[XB_TMO])) break; if (sp > XB_SPIN_CAP) { atomicAdd(&bar[XB_TMO], 1u); break; } }
    }
    nloc = mine > 0u ? mine : 1u; nx = cnt > 0u ? cnt : 1u;
}
__device__ __forceinline__ void xcd_arrive(const XcdBarrier& b) {
    asm volatile("s_waitcnt vmcnt(0)" ::: "memory");
    __syncthreads();
    if (threadIdx.x == 0) {
        unsigned* bar = b.bar;
        __builtin_amdgcn_s_waitcnt(0);
        unsigned nloc = b.st[0], nx = b.st[1];
        if (nloc == 0u) { xcd_barrier_complete(bar, b.x, nloc, nx); b.st[0] = nloc; b.st[1] = nx; }
        const unsigned old = xb_add(&bar[XB_XSUB(b.x)], 1u);
        const unsigned gen = old / nloc;
        if (old + 1u == (gen + 1u) * nloc) {
            __builtin_amdgcn_fence(__ATOMIC_RELEASE, "agent");
            asm volatile("s_waitcnt vmcnt(0)" ::: "memory");
            const unsigned og = xb_add(&bar[XB_TOP], 1u);
            const unsigned tg = og / nx;
            if (og + 1u == (tg + 1u) * nx) xb_add(&bar[XB_TOPGEN], 1u);
            (void)tg;
        }
        b.st[3] = gen;
    }
}
__device__ __forceinline__ void xcd_wait(const XcdBarrier& b) {
    if (threadIdx.x == 0) {
        unsigned* bar = b.bar;
        const unsigned tok = b.st[3];
        XB_SPIN(xb_ld(&bar[XB_TOPGEN]) == tok, bar);
        __builtin_amdgcn_fence(__ATOMIC_ACQUIRE, "agent");
        asm volatile("s_waitcnt vmcnt(0)" ::: "memory");
    }
    __syncthreads();
}
__device__ __forceinline__ void xcd_barrier(const XcdBarrier& b) { xcd_arrive(b); xcd_wait(b); }
constexpr int CW_BAR = 4096;

struct Args {
    const float* in[15]; float* out; unsigned char* ws;
    double invf[8];
    int ph_lo, ph_hi;
};

__device__ __forceinline__ void p0_transpose_item(const float* W, int K, int N, bf16* WT, const float* g, LAS float* scr, int item, int lane) {
    const int nblk = N / 32, kb = item / nblk, nb = item % nblk, k0 = 64 * kb, n0 = 32 * nb;
    float wv[32];
#pragma unroll
    for (int i = 0; i < 32; ++i) wv[i] = W[(size_t)(k0 + 2 * i + (lane >> 5)) * N + n0 + (lane & 31)];
#pragma unroll
    for (int i = 0; i < 32; ++i) { const int kk = 2 * i + (lane >> 5); const float gs = g ? g[k0 + kk] : 1.0f; scr[kk * 33 + (lane & 31)] = wv[i] * gs; }
    LDS_WAIT(); asm volatile("" ::: "memory");
    const int c = lane & 7;
#pragma unroll
    for (int j = 0; j < 4; ++j) { const int n = (lane >> 3) + 8 * j; const LAS float* s = scr + (8 * c) * 33 + n;
        v4u o; o.x = pg8::cvt_pk_bf16(s[0 * 33], s[1 * 33]); o.y = pg8::cvt_pk_bf16(s[2 * 33], s[3 * 33]); o.z = pg8::cvt_pk_bf16(s[4 * 33], s[5 * 33]); o.w = pg8::cvt_pk_bf16(s[6 * 33], s[7 * 33]);
        *(GAS v4u*)(WT + (size_t)(n0 + n) * K + k0 + 8 * c) = o; }
    LDS_WAIT(); asm volatile("" ::: "memory");
}

constexpr int I_IN = (D / 64) * (INW / 32), I_O = (D / 64) * (D / 32), I_UP = (D / 64) * (FF / 32), I_DN = (FF / 64) * (D / 32), PER_L = I_IN + I_O + I_UP + I_DN;
__device__ __forceinline__ void convert_weights(const Args& a, LAS unsigned char* lds, int gw, int NGW, int lo, int hi, int i0, int i1, int wave, int lane) {
    unsigned char* ws = a.ws;
    LAS float* scr = (LAS float*)(lds + RING_OFF + wave * 16384);
    for (int i = i0; i < i1; ++i) {
        const int it = lo + gw + i * NGW; if (it >= hi) break;
        const int l = it / PER_L; int r = it % PER_L;
        if (r < I_IN) { p0_transpose_item(a.in[6] + (size_t)l * D * INW, D, INW, (bf16*)(ws + WS_WIN) + (size_t)l * INW * D, a.in[5] + l * D, scr, r, lane); continue; } r -= I_IN;
        if (r < I_O)  { p0_transpose_item(a.in[10] + (size_t)l * D * D, D, D, (bf16*)(ws + WS_WO) + (size_t)l * D * D, nullptr, scr, r, lane); continue; } r -= I_O;
        if (r < I_UP) { p0_transpose_item(a.in[12] + (size_t)l * D * FF, D, FF, (bf16*)(ws + WS_WUP) + (size_t)l * FF * D, a.in[11] + l * D, scr, r, lane); continue; } r -= I_UP;
        p0_transpose_item(a.in[13] + (size_t)l * FF * D, FF, D, (bf16*)(ws + WS_WDN) + (size_t)l * D * FF, nullptr, scr, r, lane);
    }
}
__device__ __forceinline__ void copy_caches(const Args& a, int gt, int NGT, int i0, int i1) {
    constexpr int PER = 3968, TOTAL = DEPTH * DB * 2 * PER;
    for (int it = i0; it < i1; ++it) {
        const int b0 = gt + it * 8 * NGT; if (b0 >= TOTAL) break;
        f32x4 t[8];
#pragma unroll
        for (int u = 0; u < 8; ++u) { const int i = b0 + u * NGT; if (i < TOTAL) { const int slab = i / PER, w = i % PER, kv = slab & 1, ls = slab >> 1;
            t[u] = *((const GAS f32x4*)((kv ? a.in[3] : a.in[2]) + ((size_t)ls * 128 + 4) * 128) + w); } }
#pragma unroll
        for (int u = 0; u < 8; ++u) { const int i = b0 + u * NGT; if (i < TOTAL) { const int slab = i / PER, w = i % PER, kv = slab & 1, ls = slab >> 1;
            *((GAS f32x4*)(a.out + (kv ? OFF_NVS : OFF_NKS) + (size_t)ls * 128 * 128) + w) = t[u]; } }
    }
}
constexpr int CACHE_ITERS = 2;

__device__ __forceinline__ void phase_prologue(const Args& a, LAS unsigned char* lds, int vcu, int G, int wave, int lane, int tid) {
    unsigned char* ws = a.ws;
    const int gw = vcu * NWAVES + wave, NGW = G * NWAVES;
    convert_weights(a, lds, gw, NGW, 0, I_IN, 0, (I_IN + NGW - 1) / NGW, wave, lane);
    for (int m0 = gw; m0 < M; m0 += 2 * NGW) {
        f32x4 v[2][4];
#pragma unroll
        for (int u = 0; u < 2; ++u) { const int m = m0 + u * NGW; if (m < M) {
            const float* xrow = (m < NTP) ? a.in[0] + (size_t)m * D : a.in[1] + (size_t)(m - NTP) * D;
            const GAS f32x4* xr = (const GAS f32x4*)xrow + lane;
#pragma unroll
            for (int j = 0; j < 4; ++j) v[u][j] = xr[64 * j]; } }
#pragma unroll
        for (int u = 0; u < 2; ++u) { const int m = m0 + u * NGW; if (m < M) {
            float s = 0.f;
#pragma unroll
            for (int j = 0; j < 4; ++j) s += (v[u][j].x * v[u][j].x + v[u][j].y * v[u][j].y) + (v[u][j].z * v[u][j].z + v[u][j].w * v[u][j].w);
            s = wave_sum(s);
            GAS unsigned long long* o8 = (GAS unsigned long long*)((bf16*)(ws + WS_XB) + (size_t)m * D) + lane;
#pragma unroll
            for (int j = 0; j < 4; ++j) o8[64 * j] = (unsigned long long)pg8::cvt_pk_bf16(v[u][j].x, v[u][j].y) | ((unsigned long long)pg8::cvt_pk_bf16(v[u][j].z, v[u][j].w) << 32);
            if (lane < 16) ((float*)(ws + WS_SSQ))[(size_t)m * 16 + lane] = (lane == 0) ? s : 0.f; } }
    }
    const int gt = vcu * (NWAVES * 64) + tid, NGT = G * NWAVES * 64;
    for (int i = gt; i < NPOS * 8; i += NGT) {
        const int p = i >> 3, j = i & 7; const int pos = p < 4096 ? p : PASTLEN + (p - 4096);
        const double rev = (double)pos * a.invf[j] * 0.15915494309189535; const float fr = (float)(rev - rint(rev));
        float* rt = (float*)(ws + WS_ROT) + (size_t)i * 2; rt[0] = __builtin_amdgcn_cosf(fr); rt[1] = __builtin_amdgcn_sinf(fr);
    }
    for (int i = gt; i < 512; i += NGT) {
        const float a0 = a.in[8][i], a1 = a.in[8][512 + i], mx = fmaxf(a0, a1), e0 = expf(a0 - mx), e1 = expf(a1 - mx), p0 = e0 / (e0 + e1), p1 = e1 / (e0 + e1);
        float* lbp = (float*)(ws + WS_LB); lbp[i] = fmaxf(p0 - p0, 0.f); lbp[512 + i] = fmaxf((p0 + p1) - p0, 0.f);
    }
}

__device__ __forceinline__ void phase_final_norm(const Args& a, int vcu, int G, int wave, int lane) {
    const int gw = vcu * NWAVES + wave, NGW = G * NWAVES;
    const GAS f32x4* gp = (const GAS f32x4*)a.in[14] + lane;
    f32x4 g[4];
#pragma unroll
    for (int j = 0; j < 4; ++j) g[j] = gp[64 * j];
    for (int m = gw; m < M; m += NGW) {
        const GAS pg8::u32x2* xr = (const GAS pg8::u32x2*)((const bf16*)(a.ws + WS_XB) + (size_t)m * D) + lane;
        GAS f32x4* yr = (GAS f32x4*)(a.out + (size_t)m * D) + lane;
        f32x4 v[4]; float s = 0.f;
#pragma unroll
        for (int j = 0; j < 4; ++j) { const pg8::u32x2 w = xr[64 * j];
            v[j] = (f32x4){__builtin_bit_cast(float, w.x << 16), __builtin_bit_cast(float, w.x & 0xffff0000u), __builtin_bit_cast(float, w.y << 16), __builtin_bit_cast(float, w.y & 0xffff0000u)};
            s += (v[j].x * v[j].x + v[j].y * v[j].y) + (v[j].z * v[j].z + v[j].w * v[j].w); }
        const float rstd = __builtin_amdgcn_rsqf(wave_sum(s) * (1.0f / D) + EPS);
#pragma unroll
        for (int j = 0; j < 4; ++j) yr[64 * j] = v[j] * rstd * g[j];
    }
}

namespace att {
typedef short bf16x8 __attribute__((ext_vector_type(8)));
typedef short s16x4 __attribute__((ext_vector_type(4)));
typedef float f32x16 __attribute__((ext_vector_type(16)));
constexpr int QP = 528, KP = 144, VP = 192, Q_OFF = 0, K_OFF = 64 * QP, V_OFF = K_OFF + 192 * KP, O_OFF = V_OFF + 192 * VP, LDS_NEED = O_OFF + 8 * 4096;
static_assert(LDS_NEED <= RING_BYTES, "attention LDS map");
__device__ __forceinline__ s16x4 tr16(LAS const unsigned char* p) { return __builtin_bit_cast(s16x4, __builtin_amdgcn_ds_read_tr16_b64_v4i16((LAS s16x4*)p)); }
__device__ __forceinline__ v4u pack8(const f32x4 a, const f32x4 b) { v4u r; r.x = pkb(a[0], a[1]); r.y = pkb(a[2], a[3]); r.z = pkb(b[0], b[1]); r.w = pkb(b[2], b[3]); return r; }
#define U_PROMPT(un) ((un) < 512)
#define U_KVH(un) ((un) & 1)
#define U_Q0(un) ((((un) >> 1) & 63) * 64)
#define U_B(un) ((un) >> 7)
#define U_SB(un) (((un) - 512) >> 1)
__device__ __forceinline__ void load_unit(const int un, const bf16* PROJ, const int tid, v4u (&pf)[6], v4u (&pq)[4]) {
    const int kvh = U_KVH(un);
    if (U_PROMPT(un)) {
        const int q0 = U_Q0(un), b = U_B(un);
#pragma unroll
        for (int i = 0; i < 3; ++i) {
            const int idx = tid + 512 * i, kk = idx >> 3, c = idx & 7, tk = q0 - 128 + kk;
            pf[2 * i] = (v4u){0u, 0u, 0u, 0u}; pf[2 * i + 1] = pf[2 * i];
            if (tk >= 0) { const bf16* rp = PROJ + (size_t)(b * SEQ + tk) * INW; pf[2 * i] = *(const v4u*)(rp + C_KA + kvh * 64 + c * 8); pf[2 * i + 1] = *(const v4u*)(rp + C_VA + kvh * 64 + c * 8); }
        }
#pragma unroll
        for (int i = 0; i < 4; ++i) { const int idx = tid + 512 * i, r = idx >> 5, c16 = idx & 31; pq[i] = *(const v4u*)(PROJ + (size_t)(b * SEQ + q0 + r) * INW + C_QA + kvh * 256 + c16 * 8); }
    } else {
        pq[0] = (v4u){0u, 0u, 0u, 0u};
        if (tid < 128) pq[0] = *(const v4u*)(PROJ + (size_t)(NTP + U_SB(un) * 4 + (tid >> 5)) * INW + C_QA + kvh * 256 + (tid & 31) * 8);
    }
}
__device__ __forceinline__ void store_unit(const int un, LAS unsigned char* lds, const int tid, const v4u (&pf)[6], const v4u (&pq)[4]) {
    if (U_PROMPT(un)) {
#pragma unroll
        for (int i = 0; i < 3; ++i) { const int idx = tid + 512 * i, kk = idx >> 3, c = idx & 7; *(LAS v4u*)(lds + K_OFF + kk * KP + c * 16) = pf[2 * i]; *(LAS v4u*)(lds + V_OFF + kk * VP + c * 16) = pf[2 * i + 1]; }
#pragma unroll
        for (int i = 0; i < 4; ++i) { const int idx = tid + 512 * i, r = idx >> 5, c16 = idx & 31; *(LAS v4u*)(lds + Q_OFF + r * QP + c16 * 16) = pq[i]; }
    } else if (tid < 128) *(LAS v4u*)(lds + Q_OFF + (tid >> 5) * QP + (tid & 31) * 16) = pq[0];
}
__device__ __forceinline__ void stage_sample(const int un, LAS unsigned char* lds, const bf16* PROJ, const float* ck, const float* cv, const int tid) {
    const int sb = U_SB(un), kvh = U_KVH(un);
#pragma unroll
    for (int i = 0; i < 3; ++i) {
        const int idx = tid + 512 * i, kk = idx >> 3, c = idx & 7;
        v4u kx = (v4u){0u, 0u, 0u, 0u}, vx = kx;
        if (kk < 128) { const size_t o = ((size_t)(sb * 128 + kk) * 2 + kvh) * 64 + c * 8;
            kx = pack8(*(const f32x4*)(ck + o), *(const f32x4*)(ck + o + 4)); vx = pack8(*(const f32x4*)(cv + o), *(const f32x4*)(cv + o + 4)); }
        else if (kk < 132) { const bf16* rp = PROJ + (size_t)(NTP + sb * 4 + (kk - 128)) * INW; kx = *(const v4u*)(rp + C_KA + kvh * 64 + c * 8); vx = *(const v4u*)(rp + C_VA + kvh * 64 + c * 8); }
        *(LAS v4u*)(lds + K_OFF + kk * KP + c * 16) = kx; *(LAS v4u*)(lds + V_OFF + kk * VP + c * 16) = vx;
    }
}
template <int LEVEL>
__device__ __forceinline__ void compute(LAS unsigned char* lds, const bool active, const int hq, const int hl, const int qlrow, const size_t orow0, const int nvalid,
                                        const int kk0, const int klo, const int khi, const float* sinks, bf16* MIXB, const int lane, const int wave) {
    const int ql = lane & 31, h = lane >> 5;
    if (active && LEVEL >= 2) {
        bf16x8 qf[4];
#pragma unroll
        for (int ks = 0; ks < 4; ++ks) qf[ks] = *(const LAS bf16x8*)(lds + Q_OFF + qlrow * QP + (hl * 64 + 16 * ks + 8 * h) * 2);
        f32x16 s[5];
#pragma unroll
        for (int kt = 0; kt < 5; ++kt) {
            s[kt] = (f32x16){0.f, 0.f, 0.f, 0.f, 0.f, 0.f, 0.f, 0.f, 0.f, 0.f, 0.f, 0.f, 0.f, 0.f, 0.f, 0.f};
#pragma unroll
            for (int ks = 0; ks < 4; ++ks) { const bf16x8 a = *(const LAS bf16x8*)(lds + K_OFF + (kk0 + 32 * kt + ql) * KP + (16 * ks + 8 * h) * 2); s[kt] = __builtin_amdgcn_mfma_f32_32x32x16_bf16(a, qf[ks], s[kt], 0, 0, 0); }
        }
        if constexpr (LEVEL == 2) { asm volatile("" :: "v"(s[0]), "v"(s[1]), "v"(s[2]), "v"(s[3]), "v"(s[4])); return; }
        float mx = -INFINITY;
#pragma unroll
        for (int kt = 0; kt < 5; ++kt)
#pragma unroll
            for (int r = 0; r < 16; ++r) { const int kk = kk0 + 32 * kt + (r & 3) + 8 * (r >> 2) + 4 * h; const bool ok = (kk >= klo) && (kk <= khi); const float v = ok ? s[kt][r] : -INFINITY; s[kt][r] = v; mx = fmaxf(mx, v); }
        mx = fmaxf(mx, __shfl_xor(mx, 32));
        const float sk = sinks[hq] * LOG2E; mx = fmaxf(mx, sk);
        float sum = 0.f;
#pragma unroll
        for (int kt = 0; kt < 5; ++kt)
#pragma unroll
            for (int r = 0; r < 16; ++r) { const float p = __builtin_amdgcn_exp2f(s[kt][r] - mx); s[kt][r] = p; sum += p; }
        sum += __shfl_xor(sum, 32); sum += __builtin_amdgcn_exp2f(sk - mx);
        const float inv = __builtin_amdgcn_rcpf(sum);
        if constexpr (LEVEL == 3) { asm volatile("" :: "v"(s[0]), "v"(s[1]), "v"(s[2]), "v"(s[3]), "v"(s[4]), "v"(inv)); return; }
        f32x16 o[2];
        o[0] = (f32x16){0.f, 0.f, 0.f, 0.f, 0.f, 0.f, 0.f, 0.f, 0.f, 0.f, 0.f, 0.f, 0.f, 0.f, 0.f, 0.f}; o[1] = o[0];
        const int vrow = 4 * h + ((lane & 15) >> 2), vcol = 16 * ((lane >> 4) & 1) + 4 * (lane & 3);
#pragma unroll
        for (int kt = 0; kt < 5; ++kt)
#pragma unroll
            for (int st = 0; st < 2; ++st) {
                v4u pw; pw.x = pkb(s[kt][8 * st + 0], s[kt][8 * st + 1]); pw.y = pkb(s[kt][8 * st + 2], s[kt][8 * st + 3]); pw.z = pkb(s[kt][8 * st + 4], s[kt][8 * st + 5]); pw.w = pkb(s[kt][8 * st + 6], s[kt][8 * st + 7]);
                const bf16x8 pb = __builtin_bit_cast(bf16x8, pw);
#pragma unroll
                for (int mt = 0; mt < 2; ++mt) {
                    const LAS unsigned char* vp = lds + V_OFF + (kk0 + 32 * kt + 16 * st + vrow) * VP + (32 * mt + vcol) * 2;
                    const s16x4 lo = tr16(vp), hi = tr16(vp + 8 * VP);
                    const bf16x8 a = (bf16x8){lo[0], lo[1], lo[2], lo[3], hi[0], hi[1], hi[2], hi[3]};
                    o[mt] = __builtin_amdgcn_mfma_f32_32x32x16_bf16(a, pb, o[mt], 0, 0, 0);
                }
            }
        if constexpr (LEVEL == 4) { asm volatile("" :: "v"(o[0]), "v"(o[1]), "v"(inv)); return; }
        LAS unsigned char* ost = lds + O_OFF + wave * 4096;
#pragma unroll
        for (int mt = 0; mt < 2; ++mt)
#pragma unroll
            for (int rg = 0; rg < 4; ++rg) { pg8::u32x2 wv; wv.x = pkb(o[mt][4 * rg] * inv, o[mt][4 * rg + 1] * inv); wv.y = pkb(o[mt][4 * rg + 2] * inv, o[mt][4 * rg + 3] * inv);
                *(LAS pg8::u32x2*)(ost + ql * 128 + (((4 * mt + rg) ^ (ql & 7)) * 16) + h * 8) = wv; }
        LDS_WAIT();
#pragma unroll
        for (int i = 0; i < 4; ++i) { const int row = (lane >> 3) + 8 * i, ch = lane & 7;
            const v4u v = *(const LAS v4u*)(ost + row * 128 + ((ch ^ (row & 7)) * 16));
            if (row < nvalid) *(v4u*)(MIXB + (orow0 + row) * D + hq * 64 + ch * 8) = v; }
    }
}
template <int LEVEL>
__device__ __forceinline__ void run(LAS unsigned char* lds, const bf16* PROJ, const float* ck, const float* cv, const float* sinks, bf16* MIXB, bf16* MIXS, const int first, const int stride, const int nun, const int tid) {
    if (first >= nun) return;
    const int lane = tid & 63, wave = __builtin_amdgcn_readfirstlane(tid >> 6), ql = lane & 31;
    v4u pf[6], pq[4];
    int un = first;
    load_unit(un, PROJ, tid, pf, pq);
    for (;;) {
        store_unit(un, lds, tid, pf, pq);
        if (!U_PROMPT(un)) stage_sample(un, lds, PROJ, ck, cv, tid);
        WG_BAR();
        const int nxt = un + stride; const bool more = nxt < nun;
        if (more) load_unit(nxt, PROJ, tid, pf, pq);
        const int kvh = U_KVH(un);
        if (U_PROMPT(un)) { const int half = wave & 1, q0 = U_Q0(un); int klo = 32 * half + ql; if (128 - q0 > klo) klo = 128 - q0;
            compute<LEVEL>(lds, true, kvh * 4 + (wave >> 1), wave >> 1, 32 * half + ql, (size_t)U_B(un) * SEQ + q0 + 32 * half, 32, 32 * half, klo, 128 + 32 * half + ql, sinks, MIXB, lane, wave); }
        else { const bool v = ql < 4;
            compute<LEVEL>(lds, wave < 4, kvh * 4 + (wave & 3), wave & 3, ql & 3, (size_t)NTP + U_SB(un) * 4, 4, 0, v ? ql : 1, v ? 128 + ql : 0, sinks, MIXS, lane, wave); }
        WG_BAR();
        if (!more) break;
        un = nxt;
    }
}
}

namespace hg {
typedef short bf16x8 __attribute__((ext_vector_type(8)));
typedef short s16x4 __attribute__((ext_vector_type(4)));
typedef unsigned u32x2 __attribute__((ext_vector_type(2)));
constexpr int PQ = 272, PT = 320;
constexpr int T_Q = 0, T_KR = 8704, T_LF = 17408, T_KD = 27648, T_V = 37888, T_G = 48128, O_DEC = 56832, O_SSQ = 57344, LDS_NEED = 58368;
__device__ __forceinline__ s16x4 tr16(LAS const unsigned char* p) { return __builtin_bit_cast(s16x4, __builtin_amdgcn_ds_read_tr16_b64_v4i16((LAS s16x4*)p)); }
__device__ __forceinline__ float row16_sum(float v) {
    v += __builtin_bit_cast(float, __builtin_amdgcn_update_dpp(0, __builtin_bit_cast(int, v), 0x128, 0xf, 0xf, false));
    v += __builtin_bit_cast(float, __builtin_amdgcn_update_dpp(0, __builtin_bit_cast(int, v), 0x124, 0xf, 0xf, false));
    v += __builtin_bit_cast(float, __builtin_amdgcn_update_dpp(0, __builtin_bit_cast(int, v), 0x122, 0xf, 0xf, false));
    v += __builtin_bit_cast(float, __builtin_amdgcn_update_dpp(0, __builtin_bit_cast(int, v), 0x121, 0xf, 0xf, false));
    return v;
}
__device__ __forceinline__ bf16x8 cat(const s16x4 a, const s16x4 b) { return (bf16x8){a[0], a[1], a[2], a[3], b[0], b[1], b[2], b[3]}; }
__device__ __forceinline__ float ldsbf(LAS const unsigned char* p) { return bf2f(*(const LAS bf16*)p); }
__device__ __forceinline__ void stsbf(LAS unsigned char* p, float v) { *(LAS bf16*)p = (bf16)pkb(v, v); }
__device__ __forceinline__ bf16x8 pack8f(const f32x4 a, const f32x4 b) { v4u r; r.x = pkb(a[0], a[1]); r.y = pkb(a[2], a[3]); r.z = pkb(b[0], b[1]); r.w = pkb(b[2], b[3]); return __builtin_bit_cast(bf16x8, r); }

__device__ __forceinline__ void chunk_cumsum(LAS const unsigned char* lds, int d0, int lane, f32x4 (&bacc)[2]) {
    const int c = lane & 15, g = lane >> 4;
    const LAS unsigned char* p = lds + T_LF + (8 * g + (c >> 2)) * PT + (d0 + 4 * (c & 3)) * 2;
    const bf16x8 lfb = cat(tr16(p), tr16(p + 4 * PT));
#pragma unroll
    for (int mt = 0; mt < 2; ++mt) {
        const int t = 16 * mt + c; bf16x8 L;
#pragma unroll
        for (int j = 0; j < 8; ++j) L[j] = (8 * g + j <= t) ? (short)0x3F80 : (short)0;
        bacc[mt] = __builtin_amdgcn_mfma_f32_16x16x32_bf16(L, lfb, (f32x4){0.f, 0.f, 0.f, 0.f}, 0, 0, 0);
    }
}

__device__ __forceinline__ void pass1_item(LAS unsigned char* lds, const bf16* PROJ, float* USEG, float* DSEG, const int it, const int tid) {
    const int lane = tid & 63, wave = __builtin_amdgcn_readfirstlane(tid >> 6), c = lane & 15, g = lane >> 4, d0 = 16 * wave;
    const int chain = it >> 4, seg = it & 15, b = chain >> 2, h = chain & 3;
    const size_t row0 = (size_t)b * SEQ + seg * 256;
    const int srow = tid >> 4, sc16 = tid & 15;
    const bf16* gl = PROJ + (row0 + srow) * INW + h * 128 + sc16 * 8;
    v4u rl = *(const v4u*)(gl + C_FH), rv = *(const v4u*)(gl + C_IH);
    f32x4 S[8];
#pragma unroll
    for (int m = 0; m < 8; ++m) S[m] = (f32x4){0.f, 0.f, 0.f, 0.f};
    float logD = 0.f;
    for (int ch = 0; ch < 8; ++ch) {
        *(LAS v4u*)(lds + T_LF + srow * PT + sc16 * 16) = rl; *(LAS v4u*)(lds + T_V + srow * PT + sc16 * 16) = rv;
        if (ch < 7) { const bf16* gn = gl + (size_t)(ch + 1) * 32 * INW; rl = *(const v4u*)(gn + C_FH); rv = *(const v4u*)(gn + C_IH); }
        WG_BAR();
        f32x4 bacc[2]; chunk_cumsum(lds, d0, lane, bacc);
        const float blast = __shfl(bacc[1][3], 48 + c);
        logD += blast;
#pragma unroll
        for (int mt = 0; mt < 2; ++mt)
#pragma unroll
            for (int r = 0; r < 4; ++r) { const int t = 16 * mt + 4 * g + r; const float lf = ldsbf(lds + T_LF + t * PT + (d0 + c) * 2);
                stsbf(lds + T_KD + t * PT + (d0 + c) * 2, (1.0f - __builtin_amdgcn_exp2f(lf)) * __builtin_amdgcn_exp2f(blast - bacc[mt][r])); }
        if (g == 0) *(LAS float*)(lds + O_DEC + (d0 + c) * 4) = __builtin_amdgcn_exp2f(blast);
        WG_BAR();
        const LAS unsigned char* vp = lds + T_V + (4 * g + (c >> 2)) * PT + (d0 + 4 * (c & 3)) * 2;
        const bf16x8 vf = cat(tr16(vp), tr16(vp + 16 * PT));
#pragma unroll
        for (int m = 0; m < 8; ++m) {
            const f32x4 dc = *(const LAS f32x4*)(lds + O_DEC + (16 * m + 4 * g) * 4);
            const LAS unsigned char* kp = lds + T_KD + (4 * g + (c >> 2)) * PT + (16 * m + 4 * (c & 3)) * 2;
            const bf16x8 kf = cat(tr16(kp), tr16(kp + 16 * PT));
            S[m] = __builtin_amdgcn_mfma_f32_16x16x32_bf16(kf, vf, S[m] * dc, 0, 0, 0);
        }
        WG_BAR();
    }
    float* U = USEG + (size_t)it * 16384;
#pragma unroll
    for (int m = 0; m < 8; ++m)
#pragma unroll
        for (int r = 0; r < 4; ++r) U[(size_t)(16 * m + 4 * g + r) * 128 + d0 + c] = S[m][r];
    if (g == 0) DSEG[(size_t)it * 128 + d0 + c] = __builtin_amdgcn_exp2f(logD);
}

__device__ __forceinline__ void combine_phase(float* USEG, const float* DSEG, float* ns_p, int gt, int NGT) {
    for (int e = gt; e < 16 * 16384; e += NGT) {
        const int chain = e >> 14, idx = e & 16383, dk = idx >> 7;
        float u[16], dcy[16];
#pragma unroll
        for (int sg = 0; sg < 16; ++sg) { u[sg] = USEG[((size_t)(chain * 16 + sg) << 14) + idx]; dcy[sg] = DSEG[(size_t)(chain * 16 + sg) * 128 + dk]; }
        float S = 0.f;
#pragma unroll
        for (int sg = 0; sg < 16; ++sg) { USEG[((size_t)(chain * 16 + sg) << 14) + idx] = S; S = dcy[sg] * S + u[sg]; }
        ns_p[(size_t)chain * 16384 + idx] = S;
    }
}

constexpr int SET_BYTES = LDS_NEED;
static_assert(2 * SET_BYTES <= RING_BYTES, "two HGRN tile sets must fit the LDS ring");
__device__ __forceinline__ void p2_prepare(LAS unsigned char* lds, const int d0, const int lane) {
    const int c = lane & 15, g = lane >> 4;
    f32x4 bacc[2]; chunk_cumsum(lds, d0, lane, bacc);
    const float blast = __shfl(bacc[1][3], 48 + c);
#pragma unroll
    for (int mt = 0; mt < 2; ++mt)
#pragma unroll
        for (int r = 0; r < 4; ++r) { const int t = 16 * mt + 4 * g + r; const float bv = bacc[mt][r];
            const float lf = ldsbf(lds + T_LF + t * PT + (d0 + c) * 2), q = ldsbf(lds + T_Q + t * PQ + (d0 + c) * 2), k = 1.0f - __builtin_amdgcn_exp2f(lf);
            stsbf(lds + T_Q + t * PQ + (d0 + c) * 2, q * __builtin_amdgcn_exp2f(bv));
            stsbf(lds + T_KR + t * PQ + (d0 + c) * 2, k * __builtin_amdgcn_exp2f(fminf(-bv, 115.f)));
            stsbf(lds + T_KD + t * PT + (d0 + c) * 2, k * __builtin_amdgcn_exp2f(blast - bv)); }
    if (g == 0) *(LAS float*)(lds + O_DEC + (d0 + c) * 4) = __builtin_amdgcn_exp2f(blast);
}
__device__ __forceinline__ void pass2_item(LAS unsigned char* lds0, const bf16* PROJ, const float* USEG, const float* onorm, bf16* MIXB, const int it, const int tid) {
    const int lane = tid & 63, wave = __builtin_amdgcn_readfirstlane(tid >> 6), c = lane & 15, g = lane >> 4, d0 = 16 * wave;
    const int chain = it >> 4, seg = it & 15, b = chain >> 2, h = chain & 3;
    const size_t row0 = (size_t)b * SEQ + seg * 256;
    const int srow = tid >> 4, sc16 = tid & 15;
    const bf16* gl = PROJ + (row0 + srow) * INW + h * 128 + sc16 * 8;
    v4u rq = *(const v4u*)(gl + C_QH), rl = *(const v4u*)(gl + C_FH), rv = *(const v4u*)(gl + C_IH), rg = *(const v4u*)(gl + C_GH);
    f32x4 S[8];
    { const float* U = USEG + (size_t)it * 16384;
#pragma unroll
      for (int m = 0; m < 8; ++m)
#pragma unroll
          for (int r = 0; r < 4; ++r) S[m][r] = U[(size_t)(16 * m + 4 * g + r) * 128 + d0 + c]; }
    const float gn = onorm[d0 + c];
#define P2_WRITE_RAW(base) do { *(LAS v4u*)((base) + T_Q + srow * PQ + sc16 * 16) = rq; *(LAS v4u*)((base) + T_LF + srow * PT + sc16 * 16) = rl; \
        *(LAS v4u*)((base) + T_V + srow * PT + sc16 * 16) = rv; *(LAS v4u*)((base) + T_G + srow * PQ + sc16 * 16) = rg; } while (0)
#define P2_LOAD_RAW(ch) do { const bf16* gnx = gl + (size_t)(ch) * 32 * INW; rq = *(const v4u*)(gnx + C_QH); rl = *(const v4u*)(gnx + C_FH); rv = *(const v4u*)(gnx + C_IH); rg = *(const v4u*)(gnx + C_GH); } while (0)
    P2_WRITE_RAW(lds0); P2_LOAD_RAW(1);
    WG_BAR();
    p2_prepare(lds0, d0, lane);
    WG_BAR();
    for (int ch = 0; ch < 8; ++ch) {
        LAS unsigned char* lds = lds0 + (ch & 1) * SET_BYTES;
        LAS unsigned char* ldn = lds0 + ((ch & 1) ^ 1) * SET_BYTES;
        if (ch < 7) { P2_WRITE_RAW(ldn); if (ch < 6) P2_LOAD_RAW(ch + 2); }
        f32x4 o[2]; o[0] = (f32x4){0.f, 0.f, 0.f, 0.f}; o[1] = o[0];
#pragma unroll
        for (int ks = 0; ks < 4; ++ks) {
            const bf16x8 sb = pack8f(S[2 * ks], S[2 * ks + 1]);
#pragma unroll
            for (int mt = 0; mt < 2; ++mt) {
                const LAS unsigned char* qp = lds + T_Q + (16 * mt + c) * PQ + (32 * ks + 4 * g) * 2;
                const s16x4 a0 = *(const LAS s16x4*)qp, a1 = *(const LAS s16x4*)(qp + 32);
                o[mt] = __builtin_amdgcn_mfma_f32_16x16x32_bf16(cat(a0, a1), sb, o[mt], 0, 0, 0);
            }
        }
        f32x4 at[2][2];
#pragma unroll
        for (int ms = 0; ms < 2; ++ms)
#pragma unroll
            for (int nt = 0; nt < 2; ++nt) at[ms][nt] = (f32x4){0.f, 0.f, 0.f, 0.f};
#pragma unroll
        for (int ks = 0; ks < 4; ++ks) {
            bf16x8 ka[2], qb[2];
#pragma unroll
            for (int i = 0; i < 2; ++i) { ka[i] = *(const LAS bf16x8*)(lds + T_KR + (16 * i + c) * PQ + (32 * ks + 8 * g) * 2); qb[i] = *(const LAS bf16x8*)(lds + T_Q + (16 * i + c) * PQ + (32 * ks + 8 * g) * 2); }
#pragma unroll
            for (int ms = 0; ms < 2; ++ms)
#pragma unroll
                for (int nt = 0; nt < 2; ++nt) at[ms][nt] = __builtin_amdgcn_mfma_f32_16x16x32_bf16(ka[ms], qb[nt], at[ms][nt], 0, 0, 0);
        }
#pragma unroll
        for (int ms = 0; ms < 2; ++ms)
#pragma unroll
            for (int nt = 0; nt < 2; ++nt)
#pragma unroll
                for (int r = 0; r < 4; ++r) if (16 * ms + 4 * g + r > 16 * nt + c) at[ms][nt][r] = 0.f;
        const LAS unsigned char* vp = lds + T_V + (4 * g + (c >> 2)) * PT + (d0 + 4 * (c & 3)) * 2;
        const bf16x8 vf = cat(tr16(vp), tr16(vp + 16 * PT));
#pragma unroll
        for (int mt = 0; mt < 2; ++mt) o[mt] = __builtin_amdgcn_mfma_f32_16x16x32_bf16(pack8f(at[0][mt], at[1][mt]), vf, o[mt], 0, 0, 0);
#pragma unroll
        for (int m = 0; m < 8; ++m) {
            const f32x4 dc = *(const LAS f32x4*)(lds + O_DEC + (16 * m + 4 * g) * 4);
            const LAS unsigned char* kp = lds + T_KD + (4 * g + (c >> 2)) * PT + (16 * m + 4 * (c & 3)) * 2;
            S[m] = __builtin_amdgcn_mfma_f32_16x16x32_bf16(cat(tr16(kp), tr16(kp + 16 * PT)), vf, S[m] * dc, 0, 0, 0);
        }
#pragma unroll
        for (int mt = 0; mt < 2; ++mt)
#pragma unroll
            for (int r = 0; r < 4; ++r) { const float q2 = row16_sum(o[mt][r] * o[mt][r]);
                if (c == 0) *(LAS float*)(lds + O_SSQ + ((16 * mt + 4 * g + r) * 8 + wave) * 4) = q2; }
        WG_BAR();
        if (ch < 7) p2_prepare(ldn, d0, lane);
#pragma unroll
        for (int mt = 0; mt < 2; ++mt)
#pragma unroll
            for (int r = 0; r < 4; ++r) { const int t = 16 * mt + 4 * g + r;
                const f32x4 p0 = *(const LAS f32x4*)(lds + O_SSQ + t * 32), p1 = *(const LAS f32x4*)(lds + O_SSQ + t * 32 + 16);
                const float tot = ((p0[0] + p0[1]) + (p0[2] + p0[3])) + ((p1[0] + p1[1]) + (p1[2] + p1[3]));
                const float rstd = __builtin_amdgcn_rsqf(tot * (1.0f / 128.0f) + EPS);
                const float gate = ldsbf(lds + T_G + t * PQ + (d0 + c) * 2);
                stsbf(lds + T_KR + t * PQ + (d0 + c) * 2, o[mt][r] * rstd * gn * gate); }
        WG_BAR();
        *(v4u*)(MIXB + (row0 + ch * 32 + srow) * D + 512 + h * 128 + sc16 * 8) = *(const LAS v4u*)(lds + T_KR + srow * PQ + sc16 * 16);
    }
#undef P2_WRITE_RAW
#undef P2_LOAD_RAW
}

__device__ __forceinline__ void sample_load(const bf16* PROJ, const float* st_in, const int it, const int tid, f32x4 (&S)[8], v4u (&lw)[DS], v4u (&qw)[DS], u32x2 (&vw)[DS]) {
    const int dvq = tid & 31, rgp = tid >> 5, sb = it >> 2, h = it & 3;
    const size_t so = ((size_t)(sb * 4 + h) * 128 + rgp * 8) * 128 + 4 * dvq;
#pragma unroll
    for (int r = 0; r < 8; ++r) S[r] = *(const f32x4*)(st_in + so + (size_t)r * 128);
#pragma unroll
    for (int t = 0; t < DS; ++t) { const bf16* rp = PROJ + (size_t)(NTP + sb * 4 + t) * INW + h * 128;
        lw[t] = *(const v4u*)(rp + C_FH + rgp * 8); qw[t] = *(const v4u*)(rp + C_QH + rgp * 8); vw[t] = *(const u32x2*)(rp + C_IH + 4 * dvq); }
}
__device__ __forceinline__ void sample_compute(LAS unsigned char* lds, const bf16* PROJ, float* st_out, const float* onorm, bf16* MIXB, const int it, const int tid,
                                               f32x4 (&S)[8], const v4u (&lw)[DS], const v4u (&qw)[DS], const u32x2 (&vw)[DS]) {
    const int lane = tid & 63, wave = __builtin_amdgcn_readfirstlane(tid >> 6), dvq = tid & 31, rgp = tid >> 5;
    const int sb = it >> 2, h = it & 3;
    const size_t so = ((size_t)(sb * 4 + h) * 128 + rgp * 8) * 128 + 4 * dvq;
    LAS float* red = (LAS float*)lds; LAS float* osh = red + 16 * 128;
#pragma unroll
    for (int t = 0; t < DS; ++t) {
        const f32x4 v4 = (f32x4){__builtin_bit_cast(float, vw[t].x << 16), __builtin_bit_cast(float, vw[t].x & 0xffff0000u), __builtin_bit_cast(float, vw[t].y << 16), __builtin_bit_cast(float, vw[t].y & 0xffff0000u)};
        f32x4 po = (f32x4){0.f, 0.f, 0.f, 0.f};
#pragma unroll
        for (int r = 0; r < 8; ++r) { const unsigned lwd = lw[t][r >> 1], qwd = qw[t][r >> 1];
            const float lf = __builtin_bit_cast(float, (r & 1) ? (lwd & 0xffff0000u) : (lwd << 16)), q = __builtin_bit_cast(float, (r & 1) ? (qwd & 0xffff0000u) : (qwd << 16));
            const float f = __builtin_amdgcn_exp2f(lf), k = 1.0f - f;
            S[r] = S[r] * f + v4 * k; po += S[r] * q; }
        *(LAS f32x4*)(red + (t * 16 + rgp) * 128 + 4 * dvq) = po;
    }
#pragma unroll
    for (int r = 0; r < 8; ++r) *(f32x4*)(st_out + so + (size_t)r * 128) = S[r];
    WG_BAR();
    { const int t = tid >> 7, e = tid & 127; float a = 0.f;
#pragma unroll
      for (int j = 0; j < 16; ++j) a += red[(t * 16 + j) * 128 + e];
      osh[t * 128 + e] = a; }
    WG_BAR();
    if (wave < DS) { const int t = wave; const float a = osh[t * 128 + lane], b2 = osh[t * 128 + 64 + lane];
        const float rstd = __builtin_amdgcn_rsqf(wave_sum(a * a + b2 * b2) * (1.0f / 128.0f) + EPS);
        const size_t m = (size_t)NTP + sb * 4 + t; const bf16* gp = PROJ + m * INW + C_GH + h * 128;
        MIXB[m * D + 512 + h * 128 + lane] = (bf16)pkb1(a * rstd * onorm[lane] * bf2f(gp[lane]));
        MIXB[m * D + 512 + h * 128 + 64 + lane] = (bf16)pkb1(b2 * rstd * onorm[64 + lane] * bf2f(gp[64 + lane])); }
    WG_BAR();
}
}

namespace sg {
typedef short bf16x8 __attribute__((ext_vector_type(8)));
typedef unsigned u32x2 __attribute__((ext_vector_type(2)));
constexpr int CP = 1040, A_OFF = 0, B_OFF = 32 * CP, RED_OFF = B_OFF;
__device__ __forceinline__ void load_chunk(v4u (&r)[12], const bf16* A, const bf16* Bt, const int K, const int ntn, const int it, const int ch, const int tid) {
    const int tm = it / ntn, tn = it % ntn, row = tid >> 6, c16 = tid & 63;
    const bf16* ap = A + (size_t)(tm * 32 + row) * K + ch * 512 + c16 * 8;
    const bf16* bp = Bt + (size_t)(tn * 64 + row) * K + ch * 512 + c16 * 8;
#pragma unroll
    for (int i = 0; i < 4; ++i) r[i] = *(const v4u*)(ap + (size_t)(8 * i) * K);
#pragma unroll
    for (int i = 0; i < 8; ++i) r[4 + i] = *(const v4u*)(bp + (size_t)(8 * i) * K);
}
__device__ __forceinline__ void store_chunk(LAS unsigned char* lds, const v4u (&r)[12], const int tid) {
    const int row = tid >> 6, c16 = tid & 63;
#pragma unroll
    for (int i = 0; i < 4; ++i) *(LAS v4u*)(lds + A_OFF + (row + 8 * i) * CP + c16 * 16) = r[i];
#pragma unroll
    for (int i = 0; i < 8; ++i) *(LAS v4u*)(lds + B_OFF + (row + 8 * i) * CP + c16 * 16) = r[4 + i];
}
__device__ __forceinline__ void finish_tile(LAS unsigned char* lds, f32x4 (&acc)[2][2], const int ntn, const int it, const int kind, bf16* xb, float* ssq_w, const float pre_ssq, bf16* U,
                                            const int tid, const int c, const int g, const int sub, const int kq) {
    const int tm = it / ntn, tn = it % ntn;
    LAS float* red = (LAS float*)(lds + RED_OFF);
#pragma unroll
    for (int i = 0; i < 2; ++i)
#pragma unroll
        for (int j = 0; j < 2; ++j)
#pragma unroll
            for (int r = 0; r < 4; ++r) { red[(kq * 32 + 16 * i + 4 * g + r) * 64 + sub * 32 + 16 * j + c] = acc[i][j][r]; acc[i][j][r] = 0.f; }
    WG_BAR();
    const int row = tid >> 4, cq = tid & 15;
    f32x4 v = *(const LAS f32x4*)(red + row * 64 + 4 * cq);
#pragma unroll
    for (int q = 1; q < 4; ++q) v += *(const LAS f32x4*)(red + (q * 32 + row) * 64 + 4 * cq);
    const size_t grow = (size_t)NTP + tm * 32 + row; const int gcol = tn * 64 + 4 * cq;
    if (kind == 1) {
        float p = pre_ssq;
        p += __shfl_xor(p, 1); p += __shfl_xor(p, 2); p += __shfl_xor(p, 4); p += __shfl_xor(p, 8);
        const float rstd = __builtin_amdgcn_rsqf(p * (1.0f / 1024.0f) + EPS);
        f32x4 u;
#pragma unroll
        for (int e = 0; e < 4; ++e) { const float a = fmaxf(v[e] * rstd, 0.f); u[e] = a * a; }
        u32x2 w; w.x = pkb(u[0], u[1]); w.y = pkb(u[2], u[3]); *(u32x2*)(U + grow * FF + gcol) = w;
    } else {
        const u32x2 xo = *(const u32x2*)(xb + grow * D + gcol);
        const f32x4 x = (f32x4){__builtin_bit_cast(float, xo.x << 16), __builtin_bit_cast(float, xo.x & 0xffff0000u), __builtin_bit_cast(float, xo.y << 16), __builtin_bit_cast(float, xo.y & 0xffff0000u)} + v;
        u32x2 w; w.x = pkb(x[0], x[1]); w.y = pkb(x[2], x[3]); *(u32x2*)(xb + grow * D + gcol) = w;
        float ss = (x[0] * x[0] + x[1] * x[1]) + (x[2] * x[2] + x[3] * x[3]);
        ss += __shfl_xor(ss, 1); ss += __shfl_xor(ss, 2); ss += __shfl_xor(ss, 4); ss += __shfl_xor(ss, 8);
        if (cq == 0) ssq_w[grow * 16 + tn] = ss;
    }
    WG_BAR();
}
__device__ __forceinline__ void stream(LAS unsigned char* lds, const bf16* A, const bf16* Bt, const int K, const int ntn, const int first0, const int stride, const int nit, const int j0, const int j1, const int kind,
                                       bf16* xb, float* ssq_w, const float* ssq_r, bf16* U, const int tid) {
    const int lane = tid & 63, wave = __builtin_amdgcn_readfirstlane(tid >> 6), c = lane & 15, g = lane >> 4, sub = wave & 1, kq = wave >> 1;
    if (first0 >= nit) return;
    const int nch = K >> 9;
    const int nall = (nit - first0 + stride - 1) / stride;
    const int je = j1 < nall ? j1 : nall; if (j0 >= je) return;
    const int first = first0 + j0 * stride, Q = (je - j0) * nch;
    f32x4 acc[2][2];
#pragma unroll
    for (int i = 0; i < 2; ++i)
#pragma unroll
        for (int j = 0; j < 2; ++j) acc[i][j] = (f32x4){0.f, 0.f, 0.f, 0.f};
    v4u r[12];
    load_chunk(r, A, Bt, K, ntn, first, 0, tid);
    float pre = 0.f;
    const LAS unsigned char* ard = lds + A_OFF + c * CP + (kq * 128 + 8 * g) * 2;
    const LAS unsigned char* brd = lds + B_OFF + (sub * 32 + c) * CP + (kq * 128 + 8 * g) * 2;
    for (int q = 0; q < Q; ++q) {
        const int ti = q / nch, ch = q % nch, it = first + ti * stride;
        store_chunk(lds, r, tid);
        if (ch == 0 && kind == 1) pre = ssq_r[((size_t)NTP + (it / ntn) * 32 + (tid >> 4)) * 16 + (tid & 15)];
        WG_BAR();
        if (q + 1 < Q) { const int t1 = (q + 1) / nch; load_chunk(r, A, Bt, K, ntn, first + t1 * stride, (q + 1) % nch, tid); }
#pragma unroll
        for (int u = 0; u < 4; ++u) {
            const bf16x8 a0 = *(const LAS bf16x8*)(ard + 64 * u), a1 = *(const LAS bf16x8*)(ard + 16 * CP + 64 * u), b0 = *(const LAS bf16x8*)(brd + 64 * u), b1 = *(const LAS bf16x8*)(brd + 16 * CP + 64 * u);
            acc[0][0] = __builtin_amdgcn_mfma_f32_16x16x32_bf16(a0, b0, acc[0][0], 0, 0, 0); acc[0][1] = __builtin_amdgcn_mfma_f32_16x16x32_bf16(a0, b1, acc[0][1], 0, 0, 0);
            acc[1][0] = __builtin_amdgcn_mfma_f32_16x16x32_bf16(a1, b0, acc[1][0], 0, 0, 0); acc[1][1] = __builtin_amdgcn_mfma_f32_16x16x32_bf16(a1, b1, acc[1][1], 0, 0, 0);
        }
        WG_BAR();
        if (ch == nch - 1) finish_tile(lds, acc, ntn, it, kind, xb, ssq_w, pre, U, tid, c, g, sub, kq);
    }
}
}

__global__ void __launch_bounds__(NWAVES * 64, 2) mk_fwd(Args args) {
    extern __shared__ __attribute__((aligned(16))) unsigned char lds_raw[];
    LAS unsigned char* lds = (LAS unsigned char*)lds_raw;
    volatile LAS unsigned* MISC = (volatile LAS unsigned*)(lds + MISC_OFF);
    const int tid = threadIdx.x, lane = tid & 63, wave = __builtin_amdgcn_readfirstlane(tid >> 6);
    const int G = gridDim.x; const int bx = blockIdx.x; const int vcu = (G % 8 == 0) ? (bx % 8) * (G / 8) + bx / 8 : bx;
    unsigned char* ws = args.ws;
    gu32* ctl = (gu32*)(ws + WS_CTL);
    for (int u = tid; u < (LDS_BYTES - LDSCTL_OFF) / 4; u += NWAVES * 64) ((LAS unsigned*)(lds + LDSCTL_OFF))[u] = 0u;
    __syncthreads();
    const int lo = args.ph_lo, hi = args.ph_hi;
    XcdBarrier bar; bar.bar = (unsigned*)(ctl + CW_BAR); bar.x = 0; bar.st = nullptr;
    bar = xcd_barrier_post((unsigned*)(ctl + CW_BAR), MISC + 8);
    XcdBarrier barS = xcd_barrier_post((unsigned*)(ctl + CW_BAR) + XCD_BAR_WORDS, MISC + 12);
#define IN(k) (lo <= (k) && (k) < hi)
#define SEAM(k) do { if (IN(k) && IN((k) + 1)) xcd_barrier(bar); } while (0)

    if (IN(0)) { phase_prologue(args, lds, vcu, G, wave, lane, tid); if (IN(1)) xcd_arrive(bar); }

    for (int ph = (lo > 1 ? lo : 1); ph < (hi < 15 ? hi : 15); ++ph) {
        const int l = (ph - 1) / 7, k = (ph - 1) % 7;
        if (k == 1) {
            int tid_a = tid; asm volatile("" : "+v"(tid_a));
            const bf16* PRJ = (const bf16*)(ws + WS_PROJ); bf16* MX = (bf16*)(ws + WS_MIX); bf16* MXS = (bf16*)(ws + WS_MIXS) - (size_t)NTP * D;
            const float* st_in = args.in[4] + (size_t)l * 8388608; float* st_out = args.out + OFF_NSS + (size_t)l * 8388608; const float* onorm = args.in[9] + l * 128;
            for (int it = vcu; it < 256; it += G) hg::pass1_item(lds + RING_OFF, PRJ, (float*)(ws + WS_HG), (float*)(ws + WS_HG + 16 * MiB), it, tid_a);
            xcd_arrive(bar);
            att::run<5>(lds + RING_OFF, PRJ, args.in[2] + (size_t)l * 2097152, args.in[3] + (size_t)l * 2097152, args.in[7] + l * 8, MX, MXS, vcu, G, 768, tid_a);
            xcd_wait(bar);
            { int tid_c = tid; asm volatile("" : "+v"(tid_c));
              hg::combine_phase((float*)(ws + WS_HG), (const float*)(ws + WS_HG + 16 * MiB), args.out + OFF_NSP + (size_t)l * 262144, vcu * (NWAVES * 64) + tid_c, G * NWAVES * 64); }
            xcd_arrive(bar);
            { int tid_s = tid; asm volatile("" : "+v"(tid_s));
              f32x4 SA[8], SB[8]; v4u lwA[DS], qwA[DS], lwB[DS], qwB[DS]; hg::u32x2 vwA[DS], vwB[DS];
              for (int sa = vcu; sa < 512; sa += 2 * G) {
                  const int sb2 = sa + G;
                  hg::sample_load(PRJ, st_in, sa, tid_s, SA, lwA, qwA, vwA);
                  hg::sample_load(PRJ, st_in, sb2 < 512 ? sb2 : 511, tid_s, SB, lwB, qwB, vwB);
                  hg::sample_compute(lds + RING_OFF, PRJ, st_out, onorm, MXS, sa, tid_s, SA, lwA, qwA, vwA);
                  if (sb2 < 512) hg::sample_compute(lds + RING_OFF, PRJ, st_out, onorm, MXS, sb2, tid_s, SB, lwB, qwB, vwB);
              } }
            xcd_wait(bar);
            { int tid_p = tid; asm volatile("" : "+v"(tid_p));
              for (int it = vcu; it < 256; it += G) hg::pass2_item(lds + RING_OFF, PRJ, (const float*)(ws + WS_HG), onorm, MX, it, tid_p); }
            if (IN(ph + 2) && IN(ph + 3)) xcd_barrier(bar);
            continue;
        }
        if (k == 2 || k == 3) continue;
        bf16* XB = (bf16*)(ws + WS_XB); bf16* PROJ = (bf16*)(ws + WS_PROJ); bf16* MIXB = (bf16*)(ws + WS_MIX); bf16* UB = (bf16*)(ws + WS_U);
        pg8::Gemm g; pg8::EpiAny E{0, l, ws, args.out, args.in[0], args.in[1], WS_ROT, WS_LB, WS_SSQ, SSQ_STRIDE, WS_PROJ, WS_XB, WS_U, OFF_NKP, OFF_NVP, OFF_NKS, OFF_NVS};
        if (k == 0)      { g = pg8::Gemm{XB, (const bf16*)(ws + WS_WIN) + (size_t)l * INW * D, M, INW, D}; E.kind = 0; }
        else if (k == 4) { g = pg8::Gemm{MIXB, (const bf16*)(ws + WS_WO) + (size_t)l * D * D, NTP, D, D}; E.kind = 2; }
        else if (k == 5) { g = pg8::Gemm{XB, (const bf16*)(ws + WS_WUP) + (size_t)l * FF * D, NTP, FF, D}; E.kind = 1; }
        else             { g = pg8::Gemm{UB, (const bf16*)(ws + WS_WDN) + (size_t)l * D * FF, NTP, D, FF}; E.kind = 3; }
        pg8::StaticOrder S; S.init(g.M, g.N, G, bx);
        int tid_o = tid; asm volatile("" : "+v"(tid_o));
        const int ntn = g.N >> 6, nit = 16 * ntn, npre = (k == 5) ? (vcu & 3) : (k >= 4) ? (vcu & 1) : 0;
        float* ssq_w = (float*)(ws + WS_SSQ + (size_t)(2 * l + (k == 4 ? 1 : 2)) * SSQ_STRIDE);
        const float* ssq_r = (const float*)(ws + WS_SSQ + (size_t)(2 * l + 1) * SSQ_STRIDE);
        const int NGWf = G * NWAVES, f_lo = (l == 0) ? I_IN : PER_L + I_IN, f_hi = (l == 0) ? PER_L + I_IN : 2 * PER_L, f_n = (f_hi - f_lo + NGWf - 1) / NGWf, fgrp = vcu % 3;
        const int f_pre = (f_n * (fgrp + 1) + 2) / 3, c_pre = (l == 1) ? (fgrp + 1 < CACHE_ITERS ? fgrp + 1 : CACHE_ITERS) : 0, c_n = (l == 1) ? CACHE_ITERS : 0;
        if (k == 0) { const int lane_o = tid_o & 63;
            convert_weights(args, lds, vcu * NWAVES + wave, NGWf, f_lo, f_hi, 0, f_pre, wave, lane_o);
            copy_caches(args, vcu * (NWAVES * 64) + tid_o, G * NWAVES * 64, 0, c_pre);
            if (IN(ph - 1)) { xcd_wait(bar); if (l > 0) xcd_wait(barS); } else __syncthreads(); }
        if (k >= 4 && npre > 0) { int tid_s = tid; asm volatile("" : "+v"(tid_s));
            if (k > 4) xcd_wait(barS);
            sg::stream(lds + RING_OFF, k == 4 ? (const bf16*)(ws + WS_MIXS) : g.A + (size_t)NTP * g.K, g.Bt, g.K, ntn, vcu, G, nit, 0, npre, k == 5 ? 1 : 2, XB, ssq_w, ssq_r, UB, tid_s); }
        if (k > 4) xcd_wait(bar);
        pg8::gemm_phase<pg8::EpiAny, pg8::StaticOrder, true, true>(lds + RING_OFF, g, S, E, tid_o);
        if (k == 0) {
            int tid_f = tid; asm volatile("" : "+v"(tid_f)); const int lane_f = tid_f & 63;
            if (IN(ph + 1)) xcd_arrive(bar);
            convert_weights(args, lds, vcu * NWAVES + wave, NGWf, f_lo, f_hi, f_pre, f_n, wave, lane_f);
            copy_caches(args, vcu * (NWAVES * 64) + tid_f, G * NWAVES * 64, c_pre, c_n);
            if (IN(ph + 1)) xcd_wait(bar);
            continue;
        }
        xcd_arrive(bar);
        { int tid_s = tid; asm volatile("" : "+v"(tid_s));
            if (k > 4 && npre == 0) xcd_wait(barS);
            sg::stream(lds + RING_OFF, k == 4 ? (const bf16*)(ws + WS_MIXS) : g.A + (size_t)NTP * g.K, g.Bt, g.K, ntn, vcu, G, nit, npre, 1 << 20, k == 5 ? 1 : 2, XB, ssq_w, ssq_r, UB, tid_s);
            xcd_arrive(barS); }
        if (k == 6 && l + 1 == DEPTH) { xcd_wait(bar); xcd_wait(barS); }
    }
    if (IN(15)) phase_final_norm(args, vcu, G, wave, lane);
#undef IN
#undef SEAM
}

extern "C" void kernel_launch(void* const* d_in, const int* in_sizes, int n_in, void* d_out, int out_size, void* d_ws, size_t ws_size, hipStream_t stream) {
    static int grid = 0;
    if (grid == 0) {
        if (n_in != 15 || in_sizes[0] != NTP * D || (size_t)out_size != OUT_TOTAL || ws_size < WS_END) {
            fprintf(stderr, "kernel_launch: unexpected shapes (n_in %d, in0 %d, out %d, ws %zu)\n", n_in, n_in > 0 ? in_sizes[0] : -1, out_size, ws_size); grid = -1; return; }
        int dev = 0, cus = 0, per_cu = 0;
        if (hipGetDevice(&dev) != hipSuccess || hipDeviceGetAttribute(&cus, hipDeviceAttributeMultiprocessorCount, dev) != hipSuccess) { grid = -1; return; }
        if (hipFuncSetAttribute((const void*)mk_fwd, hipFuncAttributeMaxDynamicSharedMemorySize, LDS_BYTES) != hipSuccess) { fprintf(stderr, "kernel_launch: hipFuncSetAttribute failed\n"); grid = -1; return; }
        if (hipOccupancyMaxActiveBlocksPerMultiprocessor(&per_cu, (const void*)mk_fwd, NWAVES * 64, LDS_BYTES) != hipSuccess || per_cu < 1) { fprintf(stderr, "kernel_launch: occupancy query says %d\n", per_cu); }
        (void)hipGetLastError();
        grid = cus;
    }
    if (grid < 0) return;
    (void)hipMemsetAsync((char*)d_ws + WS_CTL, 0, CTL_ZERO_BYTES, stream);
    Args a{};
    for (int i = 0; i < 15; ++i) a.in[i] = (const float*)d_in[i];
    a.out = (float*)d_out; a.ws = (unsigned char*)d_ws;
    for (int j = 0; j < 8; ++j) a.invf[j] = pow(500000.0, -(double)j / 8.0);
    auto run = [&](int lo, int hi) { a.ph_lo = lo; a.ph_hi = hi; hipLaunchKernelGGL(mk_fwd, dim3(grid), dim3(NWAVES * 64), LDS_BYTES, stream, a); };
#ifdef PROBE_PREFIX
    run(0, PROBE_PREFIX);
    (void)hipMemsetAsync((char*)d_ws + WS_CTL, 0, CTL_ZERO_BYTES, stream);
#endif
    run(0, 16);
}
```

```cpp
#include <hip/hip_runtime.h>
#include <cstdio>
#include <cstdint>
#include <cmath>

namespace pg8 {
#define PG8_LAS __attribute__((address_space(3)))
typedef unsigned short bf16_t;
typedef short bf16x8 __attribute__((ext_vector_type(8)));
typedef float f32x4 __attribute__((ext_vector_type(4)));
typedef unsigned u32x4 __attribute__((ext_vector_type(4)));
typedef unsigned u32x2 __attribute__((ext_vector_type(2)));
constexpr int BM = 256, BK = 64, HALF = 128, HTB = HALF * BK * 2, STAGE_BYTES = 8 * HTB, NXCD = 8, WGM = 4;

__host__ __device__ __forceinline__ int lds_byte(int r, int c) { const int st = (r >> 4) * 2 + (c >> 5), rr = r & 15, cc = c & 31, ob = rr * 64 + cc * 2; return st * 1024 + (ob ^ (((ob >> 9) & 1) << 5)); }
__host__ __device__ __forceinline__ void stage_rc(int b, int& R, int& C) { const int st = b / 1024, sb = b % 1024, swz = sb ^ (((sb >> 9) & 1) << 5); R = (st >> 1) * 16 + swz / 64; C = (st & 1) * 32 + (swz % 64) / 2; }
__host__ __device__ __forceinline__ int perm32(int rho) { const int n = rho >> 4, i = rho & 15; return 8 * (i >> 2) + 4 * n + (i & 3); }

struct Unit { int pm, pn; };
struct Gemm { const bf16_t* A; const bf16_t* Bt; int M, N, K; };

struct StaticOrder {
    int nM, nN, nwg, G, c, nMm, nwgm;
    __host__ __device__ void init(int M, int N, int G_, int c_) { nM = M / BM; nN = N / BM; nwg = nM * nN; G = G_; c = c_; nMm = nM & ~7; nwgm = nMm * nN; }
    __host__ __device__ bool next(int i, Unit& u) const {
        const long L = (long)i * G + c; if (L >= nwg) return false;
        if (L >= nwgm) { const int s = (int)L - nwgm; u.pm = nMm + s / nN; u.pn = s % nN; return true; }
        int wgid = (int)L; { const int q = nwgm / NXCD, r = nwgm % NXCD, xcd = wgid % NXCD, off = wgid / NXCD; wgid = (xcd < r ? xcd * (q + 1) : r * (q + 1) + (xcd - r) * q) + off; }
        const int nig = WGM * nN, gid = wgid / nig, fm = gid * WGM, gsz = (nMm - fm) < WGM ? (nMm - fm) : WGM;
        u.pm = fm + ((wgid % nig) % gsz); u.pn = (wgid % nig) / gsz; return true;
    }
    __device__ __forceinline__ void a_ready(const Unit&) const {}
    __device__ __forceinline__ void done(const Unit&) const {}
};

__device__ __forceinline__ unsigned cvt_pk_bf16(float lo, float hi) { unsigned r; asm volatile("v_cvt_pk_bf16_f32 %0, %1, %2" : "=v"(r) : "v"(lo), "v"(hi)); return r; }

constexpr int NTOK_P = 16384, PW = 2816;
constexpr float RMS_EPS = 1e-6f;
constexpr float QSCALE = 0.125f * 1.4426950408889634f;

__device__ __forceinline__ void row_rstd8(const float* ssq, int row0, int fq, float (&rs)[8]) {
    f32x4 p[8];
#pragma unroll
    for (int i = 0; i < 8; ++i) p[i] = *(const f32x4*)(ssq + (size_t)(row0 + (i >> 2) * HALF + (i & 3) * 16) * 16 + 4 * fq);
#pragma unroll
    for (int i = 0; i < 8; ++i) { float s = (p[i][0] + p[i][1]) + (p[i][2] + p[i][3]); s += __shfl_xor(s, 16); s += __shfl_xor(s, 32); rs[i] = __builtin_amdgcn_rsqf(s * (1.0f / 1024.0f) + RMS_EPS); }
}

__device__ __forceinline__ void row_msq8(const float* ssq, int row0, int fq, float (&rs)[8]) {
    f32x4 p[8];
#pragma unroll
    for (int i = 0; i < 8; ++i) p[i] = *(const f32x4*)(ssq + (size_t)(row0 + (i >> 2) * HALF + (i & 3) * 16) * 16 + 4 * fq);
#pragma unroll
    for (int i = 0; i < 8; ++i) { float s = (p[i][0] + p[i][1]) + (p[i][2] + p[i][3]); s += __shfl_xor(s, 16); s += __shfl_xor(s, 32); rs[i] = s * (1.0f / 1024.0f) + RMS_EPS; }
}

struct EpiIn {
    static constexpr bool PERM = true, AFTER_DRAIN = false;
    __device__ __forceinline__ bool perm() const { return true; }
    bf16_t* P; const float* ssq; const float* rot; const float* lb;
    float* nk_p; float* nv_p; float* nk_s; float* nv_s;
    __device__ __forceinline__ void rot_load(f32x4 (&cs)[4], int row) const {
        const int pidx = row < NTOK_P ? (row & 4095) : 4096 + ((row - NTOK_P) & 3);
#pragma unroll
        for (int i = 0; i < 4; ++i) cs[i] = *(const f32x4*)(rot + (size_t)pidx * 16 + 4 * i);
    }
    __device__ __forceinline__ void row_part(const f32x4& a00, const f32x4& a01, const f32x4& a10, const f32x4& a11, int row, int pn, int type, bool rotw, int colw, int fq, const float r,
                                             const f32x4 (&cs)[4]) const {
#pragma unroll
        for (int bj = 0; bj < 2; ++bj) {
            float v[8];
#pragma unroll
            for (int e = 0; e < 4; ++e) { v[e] = (bj == 0 ? a00[e] : a10[e]) * r; v[4 + e] = (bj == 0 ? a01[e] : a11[e]) * r; }
            const int col = pn * BM + bj * HALF + colw;
            if (type == 0 || (type == 1 && bj == 0)) {
                if (rotw) {
#pragma unroll
                    for (int e = 0; e < 8; ++e) { const float pr = __shfl_xor(v[e], 16); const float c = cs[e >> 1][(e & 1) * 2], s = cs[e >> 1][(e & 1) * 2 + 1];
                        const float rr = (fq == 0) ? (v[e] * c - pr * s) : (v[e] * c + pr * s); v[e] = (fq < 2) ? rr : v[e]; }
                }
                if (type == 0) {
#pragma unroll
                    for (int e = 0; e < 8; ++e) v[e] *= QSCALE;
                }
            } else if (type == 2) {
#pragma unroll
                for (int e = 0; e < 8; ++e) v[e] = v[e] * __builtin_amdgcn_rcpf(1.0f + __builtin_amdgcn_exp2f(-1.4426950408889634f * v[e]));
            } else if (type == 3) {
                const f32x4 l0 = *(const f32x4*)(lb + (col - 1280)), l1 = *(const f32x4*)(lb + (col - 1280) + 4);
#pragma unroll
                for (int e = 0; e < 8; ++e) { const float lbv = e < 4 ? l0[e & 3] : l1[e & 3]; const float z = fmaxf(v[e], -80.f);
                    const float sg = __builtin_amdgcn_rcpf(1.0f + __builtin_amdgcn_exp2f(-1.4426950408889634f * z));
                    v[e] = __builtin_amdgcn_logf(lbv + (1.0f - lbv) * sg); }
            }
            u32x4 w; w.x = cvt_pk_bf16(v[0], v[1]); w.y = cvt_pk_bf16(v[2], v[3]); w.z = cvt_pk_bf16(v[4], v[5]); w.w = cvt_pk_bf16(v[6], v[7]);
            *(u32x4*)(P + (size_t)row * PW + col) = w;
            if (type == 1) {
                bool inc; float* dst;
                if (row < NTOK_P) { const int t = row & 4095, b = row >> 12; inc = t >= 3968; dst = (bj == 0 ? nk_p : nv_p) + ((size_t)(b * 128 + (t - 3968)) * 128 + colw); }
                else { const int r2 = row - NTOK_P, sb = r2 >> 2, i = r2 & 3; inc = true; dst = (bj == 0 ? nk_s : nv_s) + ((size_t)(sb * 128 + 124 + i) * 128 + colw); }
                if (inc) { *(f32x4*)dst = (f32x4){v[0], v[1], v[2], v[3]}; *(f32x4*)(dst + 4) = (f32x4){v[4], v[5], v[6], v[7]}; }
            }
        }
        asm volatile("" ::: "memory");
    }
    __device__ __forceinline__ void operator()(const f32x4 (&acc)[2][2][4][2], const Unit& u, int wr, int wc, int fr, int fq) const {
        const int pn = u.pn, row0 = u.pm * BM + wr * 64 + fr, colw = wc * 32 + 8 * fq;
        int type;
        if (pn < 2) type = 0; else if (pn == 2) type = 1; else if (pn < 5) type = 2; else if (pn < 7) type = 3; else if (pn < 9) type = 4; else type = 2;
        const bool rotw = ((wc & 1) == 0) && (type <= 1);
        float rs[8]; row_rstd8(ssq, row0, fq, rs);
        f32x4 csA[4], csB[4];
#pragma unroll
        for (int i = 0; i < 4; ++i) { csA[i] = (f32x4){0.f, 0.f, 0.f, 0.f}; csB[i] = csA[i]; }
#define EPIIN_RW(ai, m) (row0 + (ai) * HALF + (m) * 16)
#define EPIIN_ROW(ai, m, cur, nxt, nai, nm) do { if (rotw && (nai) < 2) rot_load(nxt, EPIIN_RW(nai, nm)); \
        row_part(acc[ai][0][m][0], acc[ai][0][m][1], acc[ai][1][m][0], acc[ai][1][m][1], EPIIN_RW(ai, m), pn, type, rotw, colw, fq, rs[(ai) * 4 + (m)], cur); } while (0)
        if (rotw) rot_load(csA, EPIIN_RW(0, 0));
        EPIIN_ROW(0, 0, csA, csB, 0, 1); EPIIN_ROW(0, 1, csB, csA, 0, 2); EPIIN_ROW(0, 2, csA, csB, 0, 3); EPIIN_ROW(0, 3, csB, csA, 1, 0);
        EPIIN_ROW(1, 0, csA, csB, 1, 1); EPIIN_ROW(1, 1, csB, csA, 1, 2); EPIIN_ROW(1, 2, csA, csB, 1, 3); EPIIN_ROW(1, 3, csB, csA, 2, 0);
#undef EPIIN_ROW
#undef EPIIN_RW
    }
};
struct EpiUp {
    static constexpr bool PERM = true, AFTER_DRAIN = false;
    __device__ __forceinline__ bool perm() const { return true; }
    bf16_t* O; int ldc;
    __device__ __forceinline__ void operator()(const f32x4 (&acc)[2][2][4][2], const Unit& u, int wr, int wc, int fr, int fq) const {
        const int row0 = u.pm * BM + wr * 64 + fr, col0 = u.pn * BM + wc * 32 + 8 * fq;
#pragma unroll
        for (int ai = 0; ai < 2; ++ai)
#pragma unroll
            for (int m = 0; m < 4; ++m) { bf16_t* rowp = O + (size_t)(row0 + ai * HALF + m * 16) * ldc + col0;
#pragma unroll
                for (int bj = 0; bj < 2; ++bj) { f32x4 v0 = acc[ai][bj][m][0], v1 = acc[ai][bj][m][1];
#pragma unroll
                    for (int e = 0; e < 4; ++e) { const float a = fmaxf(v0[e], 0.f), b = fmaxf(v1[e], 0.f); v0[e] = a * a; v1[e] = b * b; }
                    u32x4 w; w.x = cvt_pk_bf16(v0[0], v0[1]); w.y = cvt_pk_bf16(v0[2], v0[3]); w.z = cvt_pk_bf16(v1[0], v1[1]); w.w = cvt_pk_bf16(v1[2], v1[3]);
                    *(u32x4*)(rowp + bj * HALF) = w; } }
    }
};
struct EpiRes {
    static constexpr bool PERM = true, AFTER_DRAIN = false;
    __device__ __forceinline__ bool perm() const { return true; }
    bf16_t* xb; float* ssq;
    const float* ssq_mid; PG8_LAS float* vt;
    __device__ __forceinline__ void init(f32x4 (&acc)[2][2][4][2], const Unit& u, int wr, int wc, int fr, int fq) const {
        const int row0 = u.pm * BM + wr * 64 + fr, col0 = u.pn * BM + wc * 32 + 8 * fq;
#pragma unroll
        for (int ai = 0; ai < 2; ++ai)
#pragma unroll
            for (int m = 0; m < 4; ++m)
#pragma unroll
                for (int bj = 0; bj < 2; ++bj) { const u32x4 w = *(const u32x4*)(xb + (size_t)(row0 + ai * HALF + m * 16) * 1024 + col0 + bj * HALF);
                    acc[ai][bj][m][0] = (f32x4){__builtin_bit_cast(float, w.x << 16), __builtin_bit_cast(float, w.x & 0xffff0000u), __builtin_bit_cast(float, w.y << 16), __builtin_bit_cast(float, w.y & 0xffff0000u)};
                    acc[ai][bj][m][1] = (f32x4){__builtin_bit_cast(float, w.z << 16), __builtin_bit_cast(float, w.z & 0xffff0000u), __builtin_bit_cast(float, w.w << 16), __builtin_bit_cast(float, w.w & 0xffff0000u)}; }
        if (vt) {
            float v[8]; row_msq8(ssq_mid, row0, fq, v);
#pragma unroll
            for (int ai = 0; ai < 2; ++ai)
#pragma unroll
                for (int m = 0; m < 4; ++m) {
#pragma unroll
                    for (int bj = 0; bj < 2; ++bj) { acc[ai][bj][m][0] *= v[ai * 4 + m]; acc[ai][bj][m][1] *= v[ai * 4 + m]; }
                    if (fq == 0) vt[(wr * 4 + wc) * 128 + ai * 64 + m * 16 + fr] = v[ai * 4 + m]; }
        }
    }
    __device__ __forceinline__ void operator()(const f32x4 (&acc)[2][2][4][2], const Unit& u, int wr, int wc, int fr, int fq) const {
        const int row0 = u.pm * BM + wr * 64 + fr, col0 = u.pn * BM + wc * 32 + 8 * fq;
#pragma unroll
        for (int ai = 0; ai < 2; ++ai)
#pragma unroll
            for (int m = 0; m < 4; ++m) {
                const int row = row0 + ai * HALF + m * 16; float ss = 0.f;
                const float r2 = vt ? __builtin_amdgcn_rcpf(vt[(wr * 4 + wc) * 128 + ai * 64 + m * 16 + fr]) : 1.0f;
#pragma unroll
                for (int bj = 0; bj < 2; ++bj) {
                    const f32x4 x0 = acc[ai][bj][m][0] * r2, x1 = acc[ai][bj][m][1] * r2;
                    ss += ((x0[0] * x0[0] + x0[1] * x0[1]) + (x0[2] * x0[2] + x0[3] * x0[3])) + ((x1[0] * x1[0] + x1[1] * x1[1]) + (x1[2] * x1[2] + x1[3] * x1[3]));
                    u32x4 w; w.x = cvt_pk_bf16(x0[0], x0[1]); w.y = cvt_pk_bf16(x0[2], x0[3]); w.z = cvt_pk_bf16(x1[0], x1[1]); w.w = cvt_pk_bf16(x1[2], x1[3]);
                    *(u32x4*)(xb + (size_t)row * 1024 + col0 + bj * HALF) = w;
                }
                ss += __shfl_xor(ss, 16); ss += __shfl_xor(ss, 32);
                if (fq == 0) ssq[(size_t)row * 16 + u.pn * 4 + wc] = ss;
            }
    }
};
struct EpiFinal {
    float* out; const float* gain; float* slots; unsigned* cnt; unsigned* tmo; PG8_LAS unsigned char* sp;
    const PG8_LAS float* vt;
    __device__ __forceinline__ void operator()(const f32x4 (&acc)[2][2][4][2], const Unit& u, int wr, int wc, int fr, int fq) const {
        const int wid = wr * 4 + wc, lane = fq * 16 + fr, col0 = u.pn * BM + wc * 32 + 8 * fq;
        PG8_LAS float* P = (PG8_LAS float*)sp; PG8_LAS float* S = P + 1024; PG8_LAS unsigned* flag = (PG8_LAS unsigned*)(S + 256);
#pragma unroll
        for (int ai = 0; ai < 2; ++ai)
#pragma unroll
            for (int m = 0; m < 4; ++m) { float ss = 0.f; const float r2 = __builtin_amdgcn_rcpf(vt[wid * 128 + ai * 64 + m * 16 + fr]);
#pragma unroll
                for (int bj = 0; bj < 2; ++bj) { const f32x4 x0 = acc[ai][bj][m][0], x1 = acc[ai][bj][m][1];
                    ss += ((x0[0] * x0[0] + x0[1] * x0[1]) + (x0[2] * x0[2] + x0[3] * x0[3])) + ((x1[0] * x1[0] + x1[1] * x1[1]) + (x1[2] * x1[2] + x1[3] * x1[3])); }
                ss *= r2 * r2;
                ss += __shfl_xor(ss, 16); ss += __shfl_xor(ss, 32);
                if (fq == 0) P[(ai * HALF + wr * 64 + m * 16 + fr) * 4 + wc] = ss; }
        asm volatile("s_waitcnt lgkmcnt(0)" ::: "memory"); __builtin_amdgcn_s_barrier(); asm volatile("" ::: "memory");
        const int row = wid * 32 + (lane & 31);
        if (lane < 32) { const f32x4 p = *(const PG8_LAS f32x4*)(P + row * 4);
            __hip_atomic_store(slots + (size_t)(u.pm * BM + row) * 4 + u.pn, (p[0] + p[1]) + (p[2] + p[3]), __ATOMIC_RELAXED, __HIP_MEMORY_SCOPE_AGENT); }
        asm volatile("s_waitcnt vmcnt(0)" ::: "memory");
        if (lane == 0) __hip_atomic_fetch_add(cnt + 64 * u.pm, 1u, __ATOMIC_RELAXED, __HIP_MEMORY_SCOPE_AGENT);
        if (wid == 0) {
            unsigned spins = 0; bool dead = false;
            while ((unsigned)__builtin_amdgcn_readfirstlane(__hip_atomic_load(cnt + 64 * u.pm, __ATOMIC_RELAXED, __HIP_MEMORY_SCOPE_AGENT)) < 32u) {
                if (++spins > (1u << 20)) { dead = true; if (lane == 0) __hip_atomic_store(tmo, 1u, __ATOMIC_RELAXED, __HIP_MEMORY_SCOPE_AGENT); break; }
                __builtin_amdgcn_s_sleep(2); }
            __builtin_amdgcn_fence(__ATOMIC_ACQUIRE, "agent");
            if (lane == 0) flag[0] = dead ? 1u : 0u;
        }
        asm volatile("s_waitcnt vmcnt(0) lgkmcnt(0)" ::: "memory"); __builtin_amdgcn_s_barrier(); asm volatile("" ::: "memory");
        if (lane < 32) { const float* sl = slots + (size_t)(u.pm * BM + row) * 4; float t = 0.f;
#pragma unroll
            for (int q = 0; q < 4; ++q) t += __hip_atomic_load(sl + q, __ATOMIC_RELAXED, __HIP_MEMORY_SCOPE_AGENT);
            S[row] = __builtin_amdgcn_rsqf(t * (1.0f / 1024.0f) + RMS_EPS); }
        asm volatile("s_waitcnt lgkmcnt(0)" ::: "memory"); __builtin_amdgcn_s_barrier(); asm volatile("" ::: "memory");
        f32x4 gv[2][2];
#pragma unroll
        for (int bj = 0; bj < 2; ++bj) { gv[bj][0] = *(const f32x4*)(gain + col0 + bj * HALF); gv[bj][1] = *(const f32x4*)(gain + col0 + bj * HALF + 4); }
#pragma unroll
        for (int ai = 0; ai < 2; ++ai)
#pragma unroll
            for (int m = 0; m < 4; ++m) { const int r = ai * HALF + wr * 64 + m * 16 + fr; const float rstd = S[r] * __builtin_amdgcn_rcpf(vt[wid * 128 + ai * 64 + m * 16 + fr]); float* yp = out + (size_t)(u.pm * BM + r) * 1024 + col0;
#pragma unroll
                for (int bj = 0; bj < 2; ++bj) { *(f32x4*)(yp + bj * HALF) = acc[ai][bj][m][0] * rstd * gv[bj][0]; *(f32x4*)(yp + bj * HALF + 4) = acc[ai][bj][m][1] * rstd * gv[bj][1]; } }
    }
};
struct EpiAny {
    static constexpr bool AFTER_DRAIN = false;
    int kind, l;
    unsigned char* ws; float* out; const float* x_p; const float* x_s;
    size_t o_rot, o_lb, o_ssq, ssq_stride, o_proj, o_xb, o_u;
    size_t f_nkp, f_nvp, f_nks, f_nvs;
    const float* fgain; size_t o_fslot; int cw_fcnt; PG8_LAS unsigned char* sp;
    __device__ __forceinline__ bool perm() const { return true; }
    __device__ __forceinline__ void init(f32x4 (&acc)[2][2][4][2], const Unit& u, int wr, int wc, int fr, int fq) const {
        if (kind >= 2) { EpiRes E{(bf16_t*)(ws + o_xb), nullptr, (const float*)(ws + o_ssq + (size_t)(2 * l + 1) * ssq_stride), kind >= 3 ? (PG8_LAS float*)(sp + 6144) : nullptr}; E.init(acc, u, wr, wc, fr, fq); }
        else {
#pragma unroll
            for (int a = 0; a < 2; ++a)
#pragma unroll
                for (int b = 0; b < 2; ++b)
#pragma unroll
                    for (int m = 0; m < 4; ++m)
#pragma unroll
                        for (int n = 0; n < 2; ++n) acc[a][b][m][n] = (f32x4){0.f, 0.f, 0.f, 0.f};
        }
    }
    __device__ __forceinline__ void operator()(const f32x4 (&acc)[2][2][4][2], const Unit& u, int wr, int wc, int fr, int fq) const {
        if (kind == 0) { EpiIn E{(bf16_t*)(ws + o_proj), (const float*)(ws + o_ssq + (size_t)(2 * l) * ssq_stride), (const float*)(ws + o_rot), (const float*)(ws + o_lb) + l * 512,
                                 out + f_nkp + (size_t)l * 65536, out + f_nvp + (size_t)l * 65536, out + f_nks + (size_t)l * 2097152, out + f_nvs + (size_t)l * 2097152}; E(acc, u, wr, wc, fr, fq); }
        else if (kind == 1) { EpiUp E{(bf16_t*)(ws + o_u), 4096}; E(acc, u, wr, wc, fr, fq); }
        else if (kind == 5) { EpiFinal E{out, fgain, (float*)(ws + o_fslot), (unsigned*)ws + cw_fcnt, (unsigned*)ws, sp, (const PG8_LAS float*)(sp + 6144)}; E(acc, u, wr, wc, fr, fq); }
        else { EpiRes E{(bf16_t*)(ws + o_xb), (float*)(ws + o_ssq + (size_t)(2 * l + (kind == 2 ? 1 : 2)) * ssq_stride), nullptr, kind == 3 ? (PG8_LAS float*)(sp + 6144) : nullptr}; E(acc, u, wr, wc, fr, fq); }
    }
};

template <class Epi, class Sched, bool ALIGN_EPI = false, bool SP2 = false>
__device__ __forceinline__ void gemm_phase(PG8_LAS unsigned char* lds, const Gemm g, const Sched& S, const Epi& E, const int tid) {
    const int wid = __builtin_amdgcn_readfirstlane(tid >> 6), lane = tid & 63, wr = wid >> 2, wc = wid & 3, fr = lane & 15, fq = lane >> 4;
    const int K = g.K, nt = K / BK;
    unsigned voffA[2], voffB[2];
#pragma unroll
    for (int i = 0; i < 2; ++i) { int R, C; stage_rc(tid * 16 + i * 8192, R, C); const int Rb = E.perm() ? ((R & ~31) + perm32(R & 31)) : R;
        voffA[i] = (unsigned)(R * K + C) * 2u; voffB[i] = (unsigned)(Rb * K + C) * 2u; }
    const size_t kstep = (size_t)(BK * 2);
    const size_t hstep = (size_t)HALF * K * 2;
    const size_t tstep = 2 * hstep;
    const unsigned ldsw = (unsigned)wid * 1024u;
    const int aoff = lds_byte(wr * 64 + fr, fq * 8), boff = lds_byte(wc * 32 + fr, fq * 8);
#define PG8_SA(b, h) (((b) * 2 + (h)) * HTB)
#define PG8_SB(b, h) ((4 + (b) * 2 + (h)) * HTB)
#define PG8_STAGE(bufoff, gbase, voff) do { _Pragma("unroll") for (int _i = 0; _i < 2; ++_i) \
        __builtin_amdgcn_global_load_lds((const unsigned*)((const char*)(gbase) + (voff)[_i]), (PG8_LAS unsigned*)(lds + (bufoff) + ldsw + _i * 8192), 16, 0, 0); } while (0)
#define PG8_LDA(dst, b, h) do { _Pragma("unroll") for (int m = 0; m < 4; ++m) _Pragma("unroll") for (int k = 0; k < 2; ++k) dst[m][k] = *(const PG8_LAS bf16x8*)(lds + PG8_SA(b, h) + aoff + m * 2048 + k * 1024); } while (0)
#define PG8_LDB(dst, b, h) do { _Pragma("unroll") for (int n = 0; n < 2; ++n) _Pragma("unroll") for (int k = 0; k < 2; ++k) dst[n][k] = *(const PG8_LAS bf16x8*)(lds + PG8_SB(b, h) + boff + n * 2048 + k * 1024); } while (0)
#define PG8_MMA(ai, bj, At, Bt) do { __builtin_amdgcn_s_setprio(1); _Pragma("unroll") for (int m = 0; m < 4; ++m) _Pragma("unroll") for (int n = 0; n < 2; ++n) _Pragma("unroll") for (int k = 0; k < 2; ++k) \
        acc[ai][bj][m][n] = __builtin_amdgcn_mfma_f32_16x16x32_bf16(Bt[n][k], At[m][k], acc[ai][bj][m][n], 0, 0, 0); __builtin_amdgcn_s_setprio(0); } while (0)
#define PG8_WAIT_V(n) asm volatile("s_waitcnt vmcnt(" #n ")" ::: "memory")
#define PG8_WAIT_L(n) asm volatile("s_waitcnt lgkmcnt(" #n ")" ::: "memory")
#define PG8_BAR __builtin_amdgcn_s_barrier()
#define PG8_SCHED __builtin_amdgcn_sched_barrier(0)
    Unit cur, nxt; int ui = 0;
    if (!S.next(0, cur)) return;
    f32x4 acc[2][2][4][2];
    bf16x8 At[4][2], B0[2][2], B1[2][2];
    const char* cA = (const char*)g.A + (size_t)cur.pm * tstep; const char* cB = (const char*)g.Bt + (size_t)cur.pn * tstep;
    S.a_ready(cur);
    E.init(acc, cur, wr, wc, fr, fq);
    if constexpr (SP2) {
        PG8_STAGE(PG8_SB(0, 0), cB, voffB); PG8_STAGE(PG8_SB(0, 1), cB + hstep, voffB); PG8_STAGE(PG8_SA(0, 0), cA, voffA); PG8_STAGE(PG8_SA(0, 1), cA + hstep, voffA);
        if (wr == 1) PG8_BAR;
        PG8_WAIT_V(2); PG8_BAR;
        PG8_STAGE(PG8_SB(1, 0), cB + kstep, voffB); PG8_STAGE(PG8_SA(1, 0), cA + kstep, voffA); PG8_STAGE(PG8_SB(1, 1), cB + hstep + kstep, voffB);
        PG8_WAIT_V(6); PG8_BAR;
    } else {
        PG8_STAGE(PG8_SB(0, 0), cB, voffB); PG8_STAGE(PG8_SA(0, 0), cA, voffA); PG8_STAGE(PG8_SB(0, 1), cB + hstep, voffB); PG8_STAGE(PG8_SA(0, 1), cA + hstep, voffA);
        if (wr == 1) PG8_BAR;
        PG8_WAIT_V(4); PG8_BAR;
        PG8_STAGE(PG8_SB(1, 0), cB + kstep, voffB); PG8_STAGE(PG8_SA(1, 0), cA + kstep, voffA); PG8_STAGE(PG8_SB(1, 1), cB + hstep + kstep, voffB);
        PG8_WAIT_V(6); PG8_BAR;
    }
#pragma unroll
    for (int a = 0; a < 2; ++a)
#pragma unroll
        for (int b = 0; b < 2; ++b)
#pragma unroll
            for (int m = 0; m < 4; ++m) asm volatile("" : "+v"(acc[a][b][m][0]), "+v"(acc[a][b][m][1]));
    for (;;) {
        const bool has_next = S.next(ui + 1, nxt);
        const char* nA = has_next ? (const char*)g.A + (size_t)nxt.pm * tstep : cA; const char* nB = has_next ? (const char*)g.Bt + (size_t)nxt.pn * tstep : cB;
        for (int t = 0; t < nt; t += 2) {
            const bool last = (t == nt - 2);
            const char* a1 = cA + (size_t)(t + 1) * kstep;
            const char* a2 = last ? nA : cA + (size_t)(t + 2) * kstep; const char* b2 = last ? nB : cB + (size_t)(t + 2) * kstep;
            const char* a3 = a2 + kstep; const char* b3 = b2 + kstep;
            if (last && has_next) S.a_ready(nxt);
            if constexpr (SP2) {
            PG8_LDB(B0, 0, 0); PG8_LDB(B1, 0, 1); PG8_SCHED; PG8_LDA(At, 0, 0); PG8_STAGE(PG8_SA(1, 1), a1 + hstep, voffA);
            PG8_WAIT_V(8); PG8_WAIT_L(0); PG8_BAR; PG8_MMA(0, 0, At, B0); PG8_MMA(0, 1, At, B1); PG8_BAR; PG8_SCHED;
            PG8_LDA(At, 0, 1); PG8_STAGE(PG8_SB(0, 0), b2, voffB); PG8_STAGE(PG8_SB(0, 1), b2 + hstep, voffB); PG8_STAGE(PG8_SA(0, 0), a2, voffA);
            PG8_WAIT_V(8); PG8_WAIT_L(0); PG8_BAR; PG8_MMA(1, 0, At, B0); PG8_MMA(1, 1, At, B1); PG8_BAR; PG8_SCHED;
            PG8_LDB(B0, 1, 0); PG8_LDB(B1, 1, 1); PG8_SCHED; PG8_LDA(At, 1, 0); PG8_STAGE(PG8_SA(0, 1), a2 + hstep, voffA);
            PG8_WAIT_V(8); PG8_WAIT_L(0); PG8_BAR; PG8_MMA(0, 0, At, B0); PG8_MMA(0, 1, At, B1); PG8_BAR; PG8_SCHED;
            PG8_LDA(At, 1, 1); PG8_STAGE(PG8_SB(1, 0), b3, voffB); PG8_STAGE(PG8_SB(1, 1), b3 + hstep, voffB); PG8_STAGE(PG8_SA(1, 0), a3, voffA);
            PG8_WAIT_V(8); PG8_WAIT_L(0); PG8_BAR; PG8_MMA(1, 0, At, B0); PG8_MMA(1, 1, At, B1); PG8_BAR; PG8_SCHED;
            } else {
            PG8_LDB(B0, 0, 0); PG8_SCHED; PG8_LDA(At, 0, 0); PG8_STAGE(PG8_SA(1, 1), a1 + hstep, voffA);
            PG8_WAIT_L(8); PG8_BAR; PG8_WAIT_L(0); PG8_MMA(0, 0, At, B0); PG8_BAR; PG8_SCHED;
            PG8_LDB(B1, 0, 1); PG8_STAGE(PG8_SB(0, 0), b2, voffB);
            PG8_BAR; PG8_WAIT_L(0); PG8_MMA(0, 1, At, B1); PG8_BAR;
            PG8_LDA(At, 0, 1); PG8_STAGE(PG8_SA(0, 0), a2, voffA);
            PG8_BAR; PG8_WAIT_L(0); PG8_MMA(1, 0, At, B0); PG8_BAR; PG8_SCHED;
            PG8_STAGE(PG8_SB(0, 1), b2 + hstep, voffB);
            PG8_WAIT_V(6); PG8_BAR; PG8_MMA(1, 1, At, B1); PG8_BAR;
            PG8_LDB(B0, 1, 0); PG8_SCHED; PG8_LDA(At, 1, 0); PG8_STAGE(PG8_SA(0, 1), a2 + hstep, voffA);
            PG8_WAIT_L(8); PG8_BAR; PG8_WAIT_L(0); PG8_MMA(0, 0, At, B0); PG8_BAR; PG8_SCHED;
            PG8_LDB(B1, 1, 1); PG8_STAGE(PG8_SB(1, 0), b3, voffB);
            PG8_BAR; PG8_WAIT_L(0); PG8_MMA(0, 1, At, B1); PG8_BAR;
            PG8_LDA(At, 1, 1); PG8_STAGE(PG8_SA(1, 0), a3, voffA);
            PG8_BAR; PG8_WAIT_L(0); PG8_MMA(1, 0, At, B0); PG8_BAR; PG8_SCHED;
            PG8_STAGE(PG8_SB(1, 1), b3 + hstep, voffB);
            PG8_WAIT_V(6); PG8_BAR; PG8_MMA(1, 1, At, B1); PG8_BAR;
            }
        }
        if constexpr (ALIGN_EPI) { if (wr == 0) PG8_BAR; }
        if constexpr (!Epi::AFTER_DRAIN) {
            int l2; asm volatile("v_mbcnt_lo_u32_b32 %0, -1, 0\n\tv_mbcnt_hi_u32_b32 %0, -1, %0" : "=&v"(l2));
            E(acc, cur, wr, wc, l2 & 15, l2 >> 4); S.done(cur); }
        if (!has_next) break;
        E.init(acc, nxt, wr, wc, fr, fq);
        cur = nxt; cA = nA; cB = nB; ++ui;
        if constexpr (ALIGN_EPI) { if (wr == 1) PG8_BAR; }
    }
    PG8_WAIT_V(0);
    if constexpr (!ALIGN_EPI) { if (wr == 0) PG8_BAR; }
    PG8_BAR;
#undef PG8_SA
#undef PG8_SB
#undef PG8_STAGE
#undef PG8_LDA
#undef PG8_LDB
#undef PG8_MMA
#undef PG8_WAIT_V
#undef PG8_WAIT_L
#undef PG8_BAR
#undef PG8_SCHED
}
}

constexpr int NWAVES = 8;
#ifndef REP_PRO
#define REP_PRO 1
#endif
#ifndef REP_ATT
#define REP_ATT 1
#endif
#ifndef REP_P1
#define REP_P1 1
#endif
#ifndef REP_P2
#define REP_P2 1
#endif
#ifndef REP_SMP
#define REP_SMP 1
#endif
#ifndef REP_GIN
#define REP_GIN 1
#endif
#ifndef REP_GUP
#define REP_GUP 1
#endif
#ifndef REP_SG
#define REP_SG 1
#endif
constexpr int D = 1024, SEQ = 4096, NB = 4, NTP = NB * SEQ, DB = 128, DS = 4, NTS = DB * DS, M = NTP + NTS;
constexpr int DEPTH = 2, PASTLEN = 16384, WIN = 128;
constexpr int INW = 2816, FF = 4096;
constexpr int C_QA = 0, C_KA = 512, C_VA = 640, C_QH = 768, C_FH = 1280, C_IH = 1792, C_GH = 2304;
constexpr float EPS = 1e-6f;
constexpr float LOG2E = 1.4426950408889634f;
constexpr int NPOS = 4100;
constexpr size_t OFF_Y = 0, OFF_NKP = (size_t)M * D, OFF_NVP = OFF_NKP + 131072, OFF_NSP = OFF_NVP + 131072, OFF_NKS = OFF_NSP + 524288,
                 OFF_NVS = OFF_NKS + 4194304, OFF_NSS = OFF_NVS + 4194304, OUT_TOTAL = OFF_NSS + 16777216;
constexpr size_t MiB = 1u << 20;
constexpr size_t WS_CTL = 0, CTL_ZERO_BYTES = 96 * 1024;
constexpr int CW_FNP = 16384, CW_FNS = 20480;
constexpr size_t WS_ROT = 1 * MiB;
constexpr size_t WS_LB = 1 * MiB + 512 * 1024;
constexpr size_t WS_SSQ = 2 * MiB, SSQ_STRIDE = 1310720;
constexpr size_t WS_WIN = 10 * MiB, WS_WO = 21 * MiB, WS_WUP = 25 * MiB, WS_WDN = 41 * MiB;
constexpr size_t WS_XB = 57 * MiB;
constexpr size_t WS_HG = 90 * MiB;
constexpr size_t WS_BIG = 107 * MiB;
constexpr size_t WS_PROJ = WS_BIG, WS_MIX = 198 * MiB, WS_U = WS_BIG, WS_MIXS = 239 * MiB, WS_FSL = 240 * MiB, WS_FSLS = WS_FSL + 256 * 1024, WS_END = 241 * MiB;
static_assert(WS_SSQ + 5 * SSQ_STRIDE <= WS_WIN && WS_PROJ + (size_t)M * INW * 2 <= WS_MIX && WS_MIX + (size_t)M * D * 2 <= WS_MIXS && WS_U + (size_t)M * FF * 2 <= WS_MIXS && WS_MIXS + (size_t)NTS * D * 2 <= WS_END, "ws map");
static_assert(WS_WIN + (size_t)DEPTH * INW * D * 2 <= WS_WO && WS_XB + (size_t)M * D * 2 <= WS_HG, "ws map 2");

constexpr int RING_OFF = 0, RING_BYTES = 131072, LDSCTL_OFF = RING_BYTES, MISC_OFF = LDSCTL_OFF + 320, FIN_OFF = LDSCTL_OFF + 512, LDS_BYTES = 147456;

#define GAS __attribute__((address_space(1)))
#define LAS __attribute__((address_space(3)))
typedef unsigned short bf16;
typedef unsigned v4u __attribute__((ext_vector_type(4)));
typedef float f32x4 __attribute__((ext_vector_type(4)));
typedef GAS unsigned gu32;
#define RLX_AGENT __ATOMIC_RELAXED, __HIP_MEMORY_SCOPE_AGENT
#define LDS_WAIT() asm volatile("s_waitcnt lgkmcnt(0)" ::: "memory")
#define WG_BAR() do { asm volatile("s_waitcnt lgkmcnt(0)" ::: "memory"); __builtin_amdgcn_s_barrier(); asm volatile("" ::: "memory"); } while (0)
__device__ __forceinline__ unsigned f2bf(float f) { unsigned u = __builtin_bit_cast(unsigned, f); return (u + 0x7fffu + ((u >> 16) & 1u)) >> 16; }
__device__ __forceinline__ unsigned pk2(float lo, float hi) { return f2bf(lo) | (f2bf(hi) << 16); }
__device__ __forceinline__ unsigned pkb(float lo, float hi) { return pg8::cvt_pk_bf16(lo, hi); }
__device__ __forceinline__ unsigned pkb1(float v) { return pg8::cvt_pk_bf16(v, v); }
__device__ __forceinline__ float bf2f(bf16 v) { return __builtin_bit_cast(float, (unsigned)v << 16); }
__device__ __forceinline__ float wave_sum(float v) {
#pragma unroll
    for (int o = 1; o < 64; o <<= 1) v += __shfl_xor(v, o);
    return v;
}
__device__ __forceinline__ float wave_max(float v) {
#pragma unroll
    for (int o = 1; o < 64; o <<= 1) v = fmaxf(v, __shfl_xor(v, o));
    return v;
}

#define XB_TMO      128
#define XB_XCNT(j)  (256  + 64 * (j))
#define XB_XSUB(j)  (1280 + 64 * (j))
#define XB_XGEN(j)  (2304 + 64 * (j))
#define XB_TOP      3328
#define XB_TOPGEN   3392
#define XCD_BAR_WORDS 3456
#define XB_SPIN_CAP (1u << 18)
__device__ __forceinline__ unsigned xb_ld(unsigned* p)              { return __hip_atomic_load(p, __ATOMIC_RELAXED, __HIP_MEMORY_SCOPE_AGENT); }
__device__ __forceinline__ unsigned xb_add(unsigned* p, unsigned v) { return __hip_atomic_fetch_add(p, v, __ATOMIC_RELAXED, __HIP_MEMORY_SCOPE_AGENT); }
__device__ __forceinline__ unsigned xb_xcc_id() { return (unsigned)__builtin_amdgcn_s_getreg((3 << 11) | 20) & 0xFu; }
#define XB_SPIN(cond, bar) do { unsigned _sp = 0; while (cond) { __builtin_amdgcn_s_sleep(1); \
    if ((++_sp & 255u) == 0u) { if (xb_ld(&(bar)[XB_TMO])) break; if (_sp > XB_SPIN_CAP) { atomicAdd(&(bar)[XB_TMO], 1u); break; } } } } while (0)
struct XcdBarrier { unsigned* bar; unsigned x; volatile LAS unsigned* st; };
__device__ __forceinline__ XcdBarrier xcd_barrier_post(unsigned* bar, volatile LAS unsigned* st) {
    XcdBarrier b; b.bar = bar; b.x = xb_xcc_id(); b.st = st;
    if (threadIdx.x == 0) (void)xb_add(&bar[XB_XCNT(b.x)], 1u);
    return b;
}
__device__ __forceinline__ void xcd_barrier_complete(unsigned* bar, unsigned x, unsigned& nloc, unsigned& nx) {
    const unsigned G = gridDim.x * gridDim.y * gridDim.z;
    unsigned sum, cnt, mine, sp = 0u;
    for (;;) {
        sum = 0u; cnt = 0u; mine = 0u;
#pragma unroll
        for (unsigned j = 0; j < 16; ++j) { const unsigned c = xb_ld(&bar[XB_XCNT(j)]); sum += c; cnt += (c > 0u) ? 1u : 0u; mine = (j == x) ? c : mine; }
        if (sum == G) break;
        __builtin_amdgcn_s_sleep(1);
        if ((++sp & 255u) == 0u) { if (xb_ld(&bar[XB_TMO])) break; if (sp > XB_SPIN_CAP) { atomicAdd(&bar[XB_TMO], 1u); break; } }
    }
    nloc = mine > 0u ? mine : 1u; nx = cnt > 0u ? cnt : 1u;
}
__device__ __forceinline__ void xcd_arrive(const XcdBarrier& b) {
    asm volatile("s_waitcnt vmcnt(0)" ::: "memory");
    __syncthreads();
    if (threadIdx.x == 0) {
        unsigned* bar = b.bar;
        __builtin_amdgcn_s_waitcnt(0);
        unsigned nloc = b.st[0], nx = b.st[1];
        if (nloc == 0u) { xcd_barrier_complete(bar, b.x, nloc, nx); b.st[0] = nloc; b.st[1] = nx; }
        const unsigned old = xb_add(&bar[XB_XSUB(b.x)], 1u);
        const unsigned gen = old / nloc;
        if (old + 1u == (gen + 1u) * nloc) {
            __builtin_amdgcn_fence(__ATOMIC_RELEASE, "agent");
            asm volatile("s_waitcnt vmcnt(0)" ::: "memory");
            const unsigned og = xb_add(&bar[XB_TOP], 1u);
            const unsigned tg = og / nx;
            if (og + 1u == (tg + 1u) * nx) xb_add(&bar[XB_TOPGEN], 1u);
            (void)tg;
        }
        b.st[3] = gen;
    }
}
__device__ __forceinline__ void xcd_wait(const XcdBarrier& b) {
    if (threadIdx.x == 0) {
        unsigned* bar = b.bar;
        const unsigned tok = b.st[3];
        XB_SPIN(xb_ld(&bar[XB_TOPGEN]) == tok, bar);
        __builtin_amdgcn_fence(__ATOMIC_ACQUIRE, "agent");
        asm volatile("s_waitcnt vmcnt(0)" ::: "memory");
    }
    __syncthreads();
}
__device__ __forceinline__ void xcd_barrier(const XcdBarrier& b) { xcd_arrive(b); xcd_wait(b); }
constexpr int CW_BAR = 4096;

struct Args {
    const float* in[15]; float* out; unsigned char* ws;
    double invf[8];
    int ph_lo, ph_hi;
};

__device__ __forceinline__ void p0_transpose_item(const float* W, int K, int N, bf16* WT, const float* g, LAS float* scr, int item, int lane) {
    const int nblk = N / 32, kb = item / nblk, nb = item % nblk, k0 = 64 * kb, n0 = 32 * nb;
    float wv[32];
#pragma unroll
    for (int i = 0; i < 32; ++i) wv[i] = W[(size_t)(k0 + 2 * i + (lane >> 5)) * N + n0 + (lane & 31)];
#pragma unroll
    for (int i = 0; i < 32; ++i) { const int kk = 2 * i + (lane >> 5); const float gs = g ? g[k0 + kk] : 1.0f; scr[kk * 33 + (lane & 31)] = wv[i] * gs; }
    LDS_WAIT(); asm volatile("" ::: "memory");
    const int c = lane & 7;
#pragma unroll
    for (int j = 0; j < 4; ++j) { const int n = (lane >> 3) + 8 * j; const LAS float* s = scr + (8 * c) * 33 + n;
        v4u o; o.x = pg8::cvt_pk_bf16(s[0 * 33], s[1 * 33]); o.y = pg8::cvt_pk_bf16(s[2 * 33], s[3 * 33]); o.z = pg8::cvt_pk_bf16(s[4 * 33], s[5 * 33]); o.w = pg8::cvt_pk_bf16(s[6 * 33], s[7 * 33]);
        *(GAS v4u*)(WT + (size_t)(n0 + n) * K + k0 + 8 * c) = o; }
    LDS_WAIT(); asm volatile("" ::: "memory");
}

constexpr int I_IN = (D / 64) * (INW / 32), I_O = (D / 64) * (D / 32), I_UP = (D / 64) * (FF / 32), I_DN = (FF / 64) * (D / 32), PER_L = I_IN + I_O + I_UP + I_DN;
__device__ __forceinline__ void convert_weights(const Args& a, LAS unsigned char* lds, int gw, int NGW, int lo, int hi, int i0, int i1, int wave, int lane, int hole_lo = 1 << 30, int hole_len = 0) {
    unsigned char* ws = a.ws;
    LAS float* scr = (LAS float*)(lds + RING_OFF + wave * 16384);
    for (int i = i0; i < i1; ++i) {
        int it = lo + gw + i * NGW; if (it >= hole_lo) it += hole_len;
        if (it >= hi) break;
        const int l = it / PER_L; int r = it % PER_L;
        if (r < I_IN) { p0_transpose_item(a.in[6] + (size_t)l * D * INW, D, INW, (bf16*)(ws + WS_WIN) + (size_t)l * INW * D, a.in[5] + l * D, scr, r, lane); continue; } r -= I_IN;
        if (r < I_O)  { p0_transpose_item(a.in[10] + (size_t)l * D * D, D, D, (bf16*)(ws + WS_WO) + (size_t)l * D * D, nullptr, scr, r, lane); continue; } r -= I_O;
        if (r < I_UP) { p0_transpose_item(a.in[12] + (size_t)l * D * FF, D, FF, (bf16*)(ws + WS_WUP) + (size_t)l * FF * D, a.in[11] + l * D, scr, r, lane); continue; } r -= I_UP;
        p0_transpose_item(a.in[13] + (size_t)l * FF * D, FF, D, (bf16*)(ws + WS_WDN) + (size_t)l * D * FF, nullptr, scr, r, lane);
    }
}
__device__ __forceinline__ void copy_caches(const Args& a, int gt, int NGT, int i0, int i1) {
    constexpr int PER = 3968, TOTAL = DEPTH * DB * 2 * PER;
    for (int it = i0; it < i1; ++it) {
        const int b0 = gt + it * 8 * NGT; if (b0 >= TOTAL) break;
        f32x4 t[8];
#pragma unroll
        for (int u = 0; u < 8; ++u) { const int i = b0 + u * NGT; if (i < TOTAL) { const int slab = i / PER, w = i % PER, kv = slab & 1, ls = slab >> 1;
            t[u] = *((const GAS f32x4*)((kv ? a.in[3] : a.in[2]) + ((size_t)ls * 128 + 4) * 128) + w); } }
#pragma unroll
        for (int u = 0; u < 8; ++u) { const int i = b0 + u * NGT; if (i < TOTAL) { const int slab = i / PER, w = i % PER, kv = slab & 1, ls = slab >> 1;
            *((GAS f32x4*)(a.out + (kv ? OFF_NVS : OFF_NKS) + (size_t)ls * 128 * 128) + w) = t[u]; } }
    }
}
constexpr int CACHE_ITERS = 2;

__device__ __forceinline__ void phase_prologue(const Args& a, LAS unsigned char* lds, int vcu, int G, int wave, int lane, int tid) {
    unsigned char* ws = a.ws;
    const int gw = vcu * NWAVES + wave, NGW = G * NWAVES;
    convert_weights(a, lds, gw, NGW, 0, I_IN, 0, (I_IN + NGW - 1) / NGW, wave, lane);
    for (int m0 = gw; m0 < M; m0 += 2 * NGW) {
        f32x4 v[2][4];
#pragma unroll
        for (int u = 0; u < 2; ++u) { const int m = m0 + u * NGW; if (m < M) {
            const float* xrow = (m < NTP) ? a.in[0] + (size_t)m * D : a.in[1] + (size_t)(m - NTP) * D;
            const GAS f32x4* xr = (const GAS f32x4*)xrow + lane;
#pragma unroll
            for (int j = 0; j < 4; ++j) v[u][j] = xr[64 * j]; } }
#pragma unroll
        for (int u = 0; u < 2; ++u) { const int m = m0 + u * NGW; if (m < M) {
            float s = 0.f;
#pragma unroll
            for (int j = 0; j < 4; ++j) s += (v[u][j].x * v[u][j].x + v[u][j].y * v[u][j].y) + (v[u][j].z * v[u][j].z + v[u][j].w * v[u][j].w);
            s = wave_sum(s);
            GAS unsigned long long* o8 = (GAS unsigned long long*)((bf16*)(ws + WS_XB) + (size_t)m * D) + lane;
#pragma unroll
            for (int j = 0; j < 4; ++j) o8[64 * j] = (unsigned long long)pg8::cvt_pk_bf16(v[u][j].x, v[u][j].y) | ((unsigned long long)pg8::cvt_pk_bf16(v[u][j].z, v[u][j].w) << 32);
            if (lane < 16) ((float*)(ws + WS_SSQ))[(size_t)m * 16 + lane] = (lane == 0) ? s : 0.f; } }
    }
    const int gt = vcu * (NWAVES * 64) + tid, NGT = G * NWAVES * 64;
    for (int i = gt; i < NPOS * 8; i += NGT) {
        const int p = i >> 3, j = i & 7; const int pos = p < 4096 ? p : PASTLEN + (p - 4096);
        const double rev = (double)pos * a.invf[j] * 0.15915494309189535; const float fr = (float)(rev - rint(rev));
        float* rt = (float*)(ws + WS_ROT) + (size_t)i * 2; rt[0] = __builtin_amdgcn_cosf(fr); rt[1] = __builtin_amdgcn_sinf(fr);
    }
    for (int i = gt; i < 512; i += NGT) {
        const float a0 = a.in[8][i], a1 = a.in[8][512 + i], mx = fmaxf(a0, a1), e0 = expf(a0 - mx), e1 = expf(a1 - mx), p0 = e0 / (e0 + e1), p1 = e1 / (e0 + e1);
        float* lbp = (float*)(ws + WS_LB); lbp[i] = fmaxf(p0 - p0, 0.f); lbp[512 + i] = fmaxf((p0 + p1) - p0, 0.f);
    }
}

__device__ __forceinline__ void phase_final_norm(const Args& a, int vcu, int G, int wave, int lane) {
    const int gw = vcu * NWAVES + wave, NGW = G * NWAVES;
    const GAS f32x4* gp = (const GAS f32x4*)a.in[14] + lane;
    f32x4 g[4];
#pragma unroll
    for (int j = 0; j < 4; ++j) g[j] = gp[64 * j];
    for (int m = gw; m < M; m += NGW) {
        const GAS pg8::u32x2* xr = (const GAS pg8::u32x2*)((const bf16*)(a.ws + WS_XB) + (size_t)m * D) + lane;
        GAS f32x4* yr = (GAS f32x4*)(a.out + (size_t)m * D) + lane;
        f32x4 v[4]; float s = 0.f;
#pragma unroll
        for (int j = 0; j < 4; ++j) { const pg8::u32x2 w = xr[64 * j];
            v[j] = (f32x4){__builtin_bit_cast(float, w.x << 16), __builtin_bit_cast(float, w.x & 0xffff0000u), __builtin_bit_cast(float, w.y << 16), __builtin_bit_cast(float, w.y & 0xffff0000u)};
            s += (v[j].x * v[j].x + v[j].y * v[j].y) + (v[j].z * v[j].z + v[j].w * v[j].w); }
        const float rstd = __builtin_amdgcn_rsqf(wave_sum(s) * (1.0f / D) + EPS);
#pragma unroll
        for (int j = 0; j < 4; ++j) yr[64 * j] = v[j] * rstd * g[j];
    }
}

namespace att {
typedef short bf16x8 __attribute__((ext_vector_type(8)));
typedef short s16x4 __attribute__((ext_vector_type(4)));
typedef float f32x16 __attribute__((ext_vector_type(16)));
constexpr int QP = 528, KP = 144, VP = 192, Q_OFF = 0, K_OFF = 64 * QP, V_OFF = K_OFF + 192 * KP, O_OFF = V_OFF + 192 * VP, LDS_NEED = O_OFF + 8 * 4096;
static_assert(LDS_NEED <= RING_BYTES, "attention LDS map");
__device__ __forceinline__ s16x4 tr16(LAS const unsigned char* p) { return __builtin_bit_cast(s16x4, __builtin_amdgcn_ds_read_tr16_b64_v4i16((LAS s16x4*)p)); }
__device__ __forceinline__ v4u pack8(const f32x4 a, const f32x4 b) { v4u r; r.x = pkb(a[0], a[1]); r.y = pkb(a[2], a[3]); r.z = pkb(b[0], b[1]); r.w = pkb(b[2], b[3]); return r; }
#define U_PROMPT(un) ((un) < 512)
#define U_KVH(un) ((un) & 1)
#define U_Q0(un) ((((un) >> 1) & 63) * 64)
#define U_B(un) ((un) >> 7)
#define U_SB(un) (((un) - 512) >> 1)
__device__ __forceinline__ void load_unit(const int un, const bf16* PROJ, const int tid, v4u (&pf)[6], v4u (&pq)[4]) {
    const int kvh = U_KVH(un);
    if (U_PROMPT(un)) {
        const int q0 = U_Q0(un), b = U_B(un);
#pragma unroll
        for (int i = 0; i < 3; ++i) {
            const int idx = tid + 512 * i, kk = idx >> 3, c = idx & 7, tk = q0 - 128 + kk;
            pf[2 * i] = (v4u){0u, 0u, 0u, 0u}; pf[2 * i + 1] = pf[2 * i];
            if (tk >= 0) { const bf16* rp = PROJ + (size_t)(b * SEQ + tk) * INW; pf[2 * i] = *(const v4u*)(rp + C_KA + kvh * 64 + c * 8); pf[2 * i + 1] = *(const v4u*)(rp + C_VA + kvh * 64 + c * 8); }
        }
#pragma unroll
        for (int i = 0; i < 4; ++i) { const int idx = tid + 512 * i, r = idx >> 5, c16 = idx & 31; pq[i] = *(const v4u*)(PROJ + (size_t)(b * SEQ + q0 + r) * INW + C_QA + kvh * 256 + c16 * 8); }
    } else {
        pq[0] = (v4u){0u, 0u, 0u, 0u};
        if (tid < 128) pq[0] = *(const v4u*)(PROJ + (size_t)(NTP + U_SB(un) * 4 + (tid >> 5)) * INW + C_QA + kvh * 256 + (tid & 31) * 8);
    }
}
__device__ __forceinline__ void store_unit(const int un, LAS unsigned char* lds, const int tid, const v4u (&pf)[6], const v4u (&pq)[4]) {
    if (U_PROMPT(un)) {
#pragma unroll
        for (int i = 0; i < 3; ++i) { const int idx = tid + 512 * i, kk = idx >> 3, c = idx & 7; *(LAS v4u*)(lds + K_OFF + kk * KP + c * 16) = pf[2 * i]; *(LAS v4u*)(lds + V_OFF + kk * VP + c * 16) = pf[2 * i + 1]; }
#pragma unroll
        for (int i = 0; i < 4; ++i) { const int idx = tid + 512 * i, r = idx >> 5, c16 = idx & 31; *(LAS v4u*)(lds + Q_OFF + r * QP + c16 * 16) = pq[i]; }
    } else if (tid < 128) *(LAS v4u*)(lds + Q_OFF + (tid >> 5) * QP + (tid & 31) * 16) = pq[0];
}
__device__ __forceinline__ void stage_sample(const int un, LAS unsigned char* lds, const bf16* PROJ, const float* ck, const float* cv, const int tid) {
    const int sb = U_SB(un), kvh = U_KVH(un);
#pragma unroll
    for (int i = 0; i < 3; ++i) {
        const int idx = tid + 512 * i, kk = idx >> 3, c = idx & 7;
        v4u kx = (v4u){0u, 0u, 0u, 0u}, vx = kx;
        if (kk < 128) { const size_t o = ((size_t)(sb * 128 + kk) * 2 + kvh) * 64 + c * 8;
            kx = pack8(*(const f32x4*)(ck + o), *(const f32x4*)(ck + o + 4)); vx = pack8(*(const f32x4*)(cv + o), *(const f32x4*)(cv + o + 4)); }
        else if (kk < 132) { const bf16* rp = PROJ + (size_t)(NTP + sb * 4 + (kk - 128)) * INW; kx = *(const v4u*)(rp + C_KA + kvh * 64 + c * 8); vx = *(const v4u*)(rp + C_VA + kvh * 64 + c * 8); }
        *(LAS v4u*)(lds + K_OFF + kk * KP + c * 16) = kx; *(LAS v4u*)(lds + V_OFF + kk * VP + c * 16) = vx;
    }
}
template <int LEVEL>
__device__ __forceinline__ void compute(LAS unsigned char* lds, const bool active, const int hq, const int hl, const int qlrow, const size_t orow0, const int nvalid,
                                        const int kk0, const int klo, const int khi, const float* sinks, bf16* MIXB, const int lane, const int wave) {
    const int ql = lane & 31, h = lane >> 5;
    if (active && LEVEL >= 2) {
        bf16x8 qf[4];
#pragma unroll
        for (int ks = 0; ks < 4; ++ks) qf[ks] = *(const LAS bf16x8*)(lds + Q_OFF + qlrow * QP + (hl * 64 + 16 * ks + 8 * h) * 2);
        f32x16 s[5];
#pragma unroll
        for (int kt = 0; kt < 5; ++kt) {
            s[kt] = (f32x16){0.f, 0.f, 0.f, 0.f, 0.f, 0.f, 0.f, 0.f, 0.f, 0.f, 0.f, 0.f, 0.f, 0.f, 0.f, 0.f};
#pragma unroll
            for (int ks = 0; ks < 4; ++ks) { const bf16x8 a = *(const LAS bf16x8*)(lds + K_OFF + (kk0 + 32 * kt + ql) * KP + (16 * ks + 8 * h) * 2); s[kt] = __builtin_amdgcn_mfma_f32_32x32x16_bf16(a, qf[ks], s[kt], 0, 0, 0); }
        }
        if constexpr (LEVEL == 2) { asm volatile("" :: "v"(s[0]), "v"(s[1]), "v"(s[2]), "v"(s[3]), "v"(s[4])); return; }
        float mx = -INFINITY;
#pragma unroll
        for (int kt = 0; kt < 5; ++kt)
#pragma unroll
            for (int r = 0; r < 16; ++r) { const int kk = kk0 + 32 * kt + (r & 3) + 8 * (r >> 2) + 4 * h; const bool ok = (kk >= klo) && (kk <= khi); const float v = ok ? s[kt][r] : -INFINITY; s[kt][r] = v; mx = fmaxf(mx, v); }
        mx = fmaxf(mx, __shfl_xor(mx, 32));
        const float sk = sinks[hq] * LOG2E; mx = fmaxf(mx, sk);
        float sum = 0.f;
#pragma unroll
        for (int kt = 0; kt < 5; ++kt)
#pragma unroll
            for (int r = 0; r < 16; ++r) { const float p = __builtin_amdgcn_exp2f(s[kt][r] - mx); s[kt][r] = p; sum += p; }
        sum += __shfl_xor(sum, 32); sum += __builtin_amdgcn_exp2f(sk - mx);
        const float inv = __builtin_amdgcn_rcpf(sum);
        if constexpr (LEVEL == 3) { asm volatile("" :: "v"(s[0]), "v"(s[1]), "v"(s[2]), "v"(s[3]), "v"(s[4]), "v"(inv)); return; }
        f32x16 o[2];
        o[0] = (f32x16){0.f, 0.f, 0.f, 0.f, 0.f, 0.f, 0.f, 0.f, 0.f, 0.f, 0.f, 0.f, 0.f, 0.f, 0.f, 0.f}; o[1] = o[0];
        const int vrow = 4 * h + ((lane & 15) >> 2), vcol = 16 * ((lane >> 4) & 1) + 4 * (lane & 3);
#pragma unroll
        for (int kt = 0; kt < 5; ++kt)
#pragma unroll
            for (int st = 0; st < 2; ++st) {
                v4u pw; pw.x = pkb(s[kt][8 * st + 0], s[kt][8 * st + 1]); pw.y = pkb(s[kt][8 * st + 2], s[kt][8 * st + 3]); pw.z = pkb(s[kt][8 * st + 4], s[kt][8 * st + 5]); pw.w = pkb(s[kt][8 * st + 6], s[kt][8 * st + 7]);
                const bf16x8 pb = __builtin_bit_cast(bf16x8, pw);
#pragma unroll
                for (int mt = 0; mt < 2; ++mt) {
                    const LAS unsigned char* vp = lds + V_OFF + (kk0 + 32 * kt + 16 * st + vrow) * VP + (32 * mt + vcol) * 2;
                    const s16x4 lo = tr16(vp), hi = tr16(vp + 8 * VP);
                    const bf16x8 a = (bf16x8){lo[0], lo[1], lo[2], lo[3], hi[0], hi[1], hi[2], hi[3]};
                    o[mt] = __builtin_amdgcn_mfma_f32_32x32x16_bf16(a, pb, o[mt], 0, 0, 0);
                }
            }
        if constexpr (LEVEL == 4) { asm volatile("" :: "v"(o[0]), "v"(o[1]), "v"(inv)); return; }
        LAS unsigned char* ost = lds + O_OFF + wave * 4096;
#pragma unroll
        for (int mt = 0; mt < 2; ++mt)
#pragma unroll
            for (int rg = 0; rg < 4; ++rg) { pg8::u32x2 wv; wv.x = pkb(o[mt][4 * rg] * inv, o[mt][4 * rg + 1] * inv); wv.y = pkb(o[mt][4 * rg + 2] * inv, o[mt][4 * rg + 3] * inv);
                *(LAS pg8::u32x2*)(ost + ql * 128 + (((4 * mt + rg) ^ (ql & 7)) * 16) + h * 8) = wv; }
        LDS_WAIT();
#pragma unroll
        for (int i = 0; i < 4; ++i) { const int row = (lane >> 3) + 8 * i, ch = lane & 7;
            const v4u v = *(const LAS v4u*)(ost + row * 128 + ((ch ^ (row & 7)) * 16));
            if (row < nvalid) *(v4u*)(MIXB + (orow0 + row) * D + hq * 64 + ch * 8) = v; }
    }
}
template <int LEVEL>
__device__ __forceinline__ void run(LAS unsigned char* lds, const bf16* PROJ, const float* ck, const float* cv, const float* sinks, bf16* MIXB, bf16* MIXS, const int first, const int stride, const int nun, const int tid) {
    if (first >= nun) return;
    const int lane = tid & 63, wave = __builtin_amdgcn_readfirstlane(tid >> 6), ql = lane & 31;
    v4u pf[6], pq[4];
    int un = first;
    load_unit(un, PROJ, tid, pf, pq);
    for (;;) {
        store_unit(un, lds, tid, pf, pq);
        if (!U_PROMPT(un)) stage_sample(un, lds, PROJ, ck, cv, tid);
        WG_BAR();
        const int nxt = un + stride; const bool more = nxt < nun;
        if (more) load_unit(nxt, PROJ, tid, pf, pq);
        const int kvh = U_KVH(un);
        if (U_PROMPT(un)) { const int half = wave & 1, q0 = U_Q0(un); int klo = 32 * half + ql; if (128 - q0 > klo) klo = 128 - q0;
            compute<LEVEL>(lds, true, kvh * 4 + (wave >> 1), wave >> 1, 32 * half + ql, (size_t)U_B(un) * SEQ + q0 + 32 * half, 32, 32 * half, klo, 128 + 32 * half + ql, sinks, MIXB, lane, wave); }
        else { const bool v = ql < 4;
            compute<LEVEL>(lds, wave < 4, kvh * 4 + (wave & 3), wave & 3, ql & 3, (size_t)NTP + U_SB(un) * 4, 4, 0, v ? ql : 1, v ? 128 + ql : 0, sinks, MIXS, lane, wave); }
        WG_BAR();
        if (!more) break;
        un = nxt;
    }
}
}

namespace hg {
typedef short bf16x8 __attribute__((ext_vector_type(8)));
typedef short s16x4 __attribute__((ext_vector_type(4)));
typedef unsigned u32x2 __attribute__((ext_vector_type(2)));
constexpr int PQ = 272, PT = 320;
constexpr int T_Q = 0, T_KR = 8704, T_LF = 17408, T_KD = 27648, T_V = 37888, T_G = 48128, O_DEC = 56832, O_SSQ = 57344, LDS_NEED = 58368;
__device__ __forceinline__ s16x4 tr16(LAS const unsigned char* p) { return __builtin_bit_cast(s16x4, __builtin_amdgcn_ds_read_tr16_b64_v4i16((LAS s16x4*)p)); }
__device__ __forceinline__ float row16_sum(float v) {
    v += __builtin_bit_cast(float, __builtin_amdgcn_update_dpp(0, __builtin_bit_cast(int, v), 0x128, 0xf, 0xf, false));
    v += __builtin_bit_cast(float, __builtin_amdgcn_update_dpp(0, __builtin_bit_cast(int, v), 0x124, 0xf, 0xf, false));
    v += __builtin_bit_cast(float, __builtin_amdgcn_update_dpp(0, __builtin_bit_cast(int, v), 0x122, 0xf, 0xf, false));
    v += __builtin_bit_cast(float, __builtin_amdgcn_update_dpp(0, __builtin_bit_cast(int, v), 0x121, 0xf, 0xf, false));
    return v;
}
__device__ __forceinline__ bf16x8 cat(const s16x4 a, const s16x4 b) { return (bf16x8){a[0], a[1], a[2], a[3], b[0], b[1], b[2], b[3]}; }
__device__ __forceinline__ float ldsbf(LAS const unsigned char* p) { return bf2f(*(const LAS bf16*)p); }
__device__ __forceinline__ void stsbf(LAS unsigned char* p, float v) { *(LAS bf16*)p = (bf16)pkb(v, v); }
__device__ __forceinline__ bf16x8 pack8f(const f32x4 a, const f32x4 b) { v4u r; r.x = pkb(a[0], a[1]); r.y = pkb(a[2], a[3]); r.z = pkb(b[0], b[1]); r.w = pkb(b[2], b[3]); return __builtin_bit_cast(bf16x8, r); }

__device__ __forceinline__ void chunk_cumsum(LAS const unsigned char* lds, int d0, int lane, f32x4 (&bacc)[2]) {
    const int c = lane & 15, g = lane >> 4;
    const LAS unsigned char* p = lds + T_LF + (8 * g + (c >> 2)) * PT + (d0 + 4 * (c & 3)) * 2;
    const bf16x8 lfb = cat(tr16(p), tr16(p + 4 * PT));
#pragma unroll
    for (int mt = 0; mt < 2; ++mt) {
        const int t = 16 * mt + c; bf16x8 L;
#pragma unroll
        for (int j = 0; j < 8; ++j) L[j] = (8 * g + j <= t) ? (short)0x3F80 : (short)0;
        bacc[mt] = __builtin_amdgcn_mfma_f32_16x16x32_bf16(L, lfb, (f32x4){0.f, 0.f, 0.f, 0.f}, 0, 0, 0);
    }
}

__device__ __forceinline__ void pass1_item(LAS unsigned char* lds, const bf16* PROJ, float* USEG, float* DSEG, const int it, const int tid) {
    const int lane = tid & 63, wave = __builtin_amdgcn_readfirstlane(tid >> 6), c = lane & 15, g = lane >> 4, d0 = 16 * wave;
    const int chain = it >> 4, seg = it & 15, b = chain >> 2, h = chain & 3;
    const size_t row0 = (size_t)b * SEQ + seg * 256;
    const int srow = tid >> 4, sc16 = tid & 15;
    const bf16* gl = PROJ + (row0 + srow) * INW + h * 128 + sc16 * 8;
    v4u rl = *(const v4u*)(gl + C_FH), rv = *(const v4u*)(gl + C_IH);
    f32x4 S[8];
#pragma unroll
    for (int m = 0; m < 8; ++m) S[m] = (f32x4){0.f, 0.f, 0.f, 0.f};
    float logD = 0.f;
    for (int ch = 0; ch < 8; ++ch) {
        *(LAS v4u*)(lds + T_LF + srow * PT + sc16 * 16) = rl; *(LAS v4u*)(lds + T_V + srow * PT + sc16 * 16) = rv;
        if (ch < 7) { const bf16* gn = gl + (size_t)(ch + 1) * 32 * INW; rl = *(const v4u*)(gn + C_FH); rv = *(const v4u*)(gn + C_IH); }
        WG_BAR();
        f32x4 bacc[2]; chunk_cumsum(lds, d0, lane, bacc);
        const float blast = __shfl(bacc[1][3], 48 + c);
        logD += blast;
#pragma unroll
        for (int mt = 0; mt < 2; ++mt)
#pragma unroll
            for (int r = 0; r < 4; ++r) { const int t = 16 * mt + 4 * g + r; const float lf = ldsbf(lds + T_LF + t * PT + (d0 + c) * 2);
                stsbf(lds + T_KD + t * PT + (d0 + c) * 2, (1.0f - __builtin_amdgcn_exp2f(lf)) * __builtin_amdgcn_exp2f(blast - bacc[mt][r])); }
        if (g == 0) *(LAS float*)(lds + O_DEC + (d0 + c) * 4) = __builtin_amdgcn_exp2f(blast);
        WG_BAR();
        const LAS unsigned char* vp = lds + T_V + (4 * g + (c >> 2)) * PT + (d0 + 4 * (c & 3)) * 2;
        const bf16x8 vf = cat(tr16(vp), tr16(vp + 16 * PT));
#pragma unroll
        for (int m = 0; m < 8; ++m) {
            const f32x4 dc = *(const LAS f32x4*)(lds + O_DEC + (16 * m + 4 * g) * 4);
            const LAS unsigned char* kp = lds + T_KD + (4 * g + (c >> 2)) * PT + (16 * m + 4 * (c & 3)) * 2;
            const bf16x8 kf = cat(tr16(kp), tr16(kp + 16 * PT));
            S[m] = __builtin_amdgcn_mfma_f32_16x16x32_bf16(kf, vf, S[m] * dc, 0, 0, 0);
        }
        WG_BAR();
    }
    bf16* U = (bf16*)USEG + (size_t)it * 16384;
#pragma unroll
    for (int m = 0; m < 8; ++m) { u32x2 w; w.x = pkb(S[m][0], S[m][1]); w.y = pkb(S[m][2], S[m][3]); *(u32x2*)(U + ((wave * 8 + m) * 64 + lane) * 4) = w; }
    if (g == 0) DSEG[(size_t)it * 128 + d0 + c] = __builtin_amdgcn_exp2f(logD);
}

__device__ __forceinline__ void combine_phase(float* USEG, const float* DSEG, float* ns_p, int gt, int NGT) {
    unsigned* U32 = (unsigned*)USEG;
    for (int p = gt; p < 16 * 8192; p += NGT) {
        const int chain = p >> 13, q = p & 8191, e = 2 * q, r0 = e & 3, ln = (e >> 2) & 63, m = (e >> 8) & 7, wv = e >> 11;
        const int dk = 16 * m + 4 * (ln >> 4) + r0, dv = 16 * wv + (ln & 15);
        unsigned u[16]; float d0[16], d1[16];
#pragma unroll
        for (int sg = 0; sg < 16; ++sg) { u[sg] = U32[((size_t)(chain * 16 + sg) << 13) + q]; d0[sg] = DSEG[(size_t)(chain * 16 + sg) * 128 + dk]; d1[sg] = DSEG[(size_t)(chain * 16 + sg) * 128 + dk + 1]; }
        float S0 = 0.f, S1 = 0.f;
#pragma unroll
        for (int sg = 0; sg < 16; ++sg) { U32[((size_t)(chain * 16 + sg) << 13) + q] = pkb(S0, S1);
            S0 = d0[sg] * S0 + __builtin_bit_cast(float, u[sg] << 16); S1 = d1[sg] * S1 + __builtin_bit_cast(float, u[sg] & 0xffff0000u); }
        ns_p[(size_t)chain * 16384 + dk * 128 + dv] = S0; ns_p[(size_t)chain * 16384 + (dk + 1) * 128 + dv] = S1;
    }
}

constexpr int SET_BYTES = LDS_NEED;
static_assert(2 * SET_BYTES <= RING_BYTES, "two HGRN tile sets must fit the LDS ring");
__device__ __forceinline__ void p2_prepare(LAS unsigned char* lds, const int d0, const int lane) {
    const int c = lane & 15, g = lane >> 4;
    f32x4 bacc[2]; chunk_cumsum(lds, d0, lane, bacc);
    const float blast = __shfl(bacc[1][3], 48 + c);
#pragma unroll
    for (int mt = 0; mt < 2; ++mt)
#pragma unroll
        for (int r = 0; r < 4; ++r) { const int t = 16 * mt + 4 * g + r; const float bv = bacc[mt][r];
            const float lf = ldsbf(lds + T_LF + t * PT + (d0 + c) * 2), q = ldsbf(lds + T_Q + t * PQ + (d0 + c) * 2), k = 1.0f - __builtin_amdgcn_exp2f(lf);
            stsbf(lds + T_Q + t * PQ + (d0 + c) * 2, q * __builtin_amdgcn_exp2f(bv));
            stsbf(lds + T_KR + t * PQ + (d0 + c) * 2, k * __builtin_amdgcn_exp2f(fminf(-bv, 115.f)));
            stsbf(lds + T_KD + t * PT + (d0 + c) * 2, k * __builtin_amdgcn_exp2f(blast - bv)); }
    if (g == 0) *(LAS float*)(lds + O_DEC + (d0 + c) * 4) = __builtin_amdgcn_exp2f(blast);
}
__device__ __forceinline__ void pass2_item(LAS unsigned char* lds0, const bf16* PROJ, const float* USEG, const float* onorm, bf16* MIXB, const int it, const int tid) {
    const int lane = tid & 63, wave = __builtin_amdgcn_readfirstlane(tid >> 6), c = lane & 15, g = lane >> 4, d0 = 16 * wave;
    const int chain = it >> 4, seg = it & 15, b = chain >> 2, h = chain & 3;
    const size_t row0 = (size_t)b * SEQ + seg * 256;
    const int srow = tid >> 4, sc16 = tid & 15;
    const bf16* gl = PROJ + (row0 + srow) * INW + h * 128 + sc16 * 8;
    v4u rq = *(const v4u*)(gl + C_QH), rl = *(const v4u*)(gl + C_FH), rv = *(const v4u*)(gl + C_IH), rg = *(const v4u*)(gl + C_GH);
    f32x4 S[8];
    { const bf16* U = (const bf16*)USEG + (size_t)it * 16384;
#pragma unroll
      for (int m = 0; m < 8; ++m) { const u32x2 w = *(const u32x2*)(U + ((wave * 8 + m) * 64 + lane) * 4);
          S[m] = (f32x4){__builtin_bit_cast(float, w.x << 16), __builtin_bit_cast(float, w.x & 0xffff0000u), __builtin_bit_cast(float, w.y << 16), __builtin_bit_cast(float, w.y & 0xffff0000u)}; } }
    const float gn = onorm[d0 + c];
#define P2_WRITE_RAW(base) do { *(LAS v4u*)((base) + T_Q + srow * PQ + sc16 * 16) = rq; *(LAS v4u*)((base) + T_LF + srow * PT + sc16 * 16) = rl; \
        *(LAS v4u*)((base) + T_V + srow * PT + sc16 * 16) = rv; *(LAS v4u*)((base) + T_G + srow * PQ + sc16 * 16) = rg; } while (0)
#define P2_LOAD_RAW(ch) do { const bf16* gnx = gl + (size_t)(ch) * 32 * INW; rq = *(const v4u*)(gnx + C_QH); rl = *(const v4u*)(gnx + C_FH); rv = *(const v4u*)(gnx + C_IH); rg = *(const v4u*)(gnx + C_GH); } while (0)
    P2_WRITE_RAW(lds0); P2_LOAD_RAW(1);
    WG_BAR();
    p2_prepare(lds0, d0, lane);
    WG_BAR();
    for (int ch = 0; ch < 8; ++ch) {
        LAS unsigned char* lds = lds0 + (ch & 1) * SET_BYTES;
        LAS unsigned char* ldn = lds0 + ((ch & 1) ^ 1) * SET_BYTES;
        if (ch < 7) { P2_WRITE_RAW(ldn); if (ch < 6) P2_LOAD_RAW(ch + 2); }
        f32x4 o[2]; o[0] = (f32x4){0.f, 0.f, 0.f, 0.f}; o[1] = o[0];
#pragma unroll
        for (int ks = 0; ks < 4; ++ks) {
            const bf16x8 sb = pack8f(S[2 * ks], S[2 * ks + 1]);
#pragma unroll
            for (int mt = 0; mt < 2; ++mt) {
                const LAS unsigned char* qp = lds + T_Q + (16 * mt + c) * PQ + (32 * ks + 4 * g) * 2;
                const s16x4 a0 = *(const LAS s16x4*)qp, a1 = *(const LAS s16x4*)(qp + 32);
                o[mt] = __builtin_amdgcn_mfma_f32_16x16x32_bf16(cat(a0, a1), sb, o[mt], 0, 0, 0);
            }
        }
        f32x4 at[2][2];
#pragma unroll
        for (int ms = 0; ms < 2; ++ms)
#pragma unroll
            for (int nt = 0; nt < 2; ++nt) at[ms][nt] = (f32x4){0.f, 0.f, 0.f, 0.f};
#pragma unroll
        for (int ks = 0; ks < 4; ++ks) {
            bf16x8 ka[2], qb[2];
#pragma unroll
            for (int i = 0; i < 2; ++i) { ka[i] = *(const LAS bf16x8*)(lds + T_KR + (16 * i + c) * PQ + (32 * ks + 8 * g) * 2); qb[i] = *(const LAS bf16x8*)(lds + T_Q + (16 * i + c) * PQ + (32 * ks + 8 * g) * 2); }
#pragma unroll
            for (int ms = 0; ms < 2; ++ms)
#pragma unroll
                for (int nt = 0; nt < 2; ++nt) at[ms][nt] = __builtin_amdgcn_mfma_f32_16x16x32_bf16(ka[ms], qb[nt], at[ms][nt], 0, 0, 0);
        }
#pragma unroll
        for (int ms = 0; ms < 2; ++ms)
#pragma unroll
            for (int nt = 0; nt < 2; ++nt)
#pragma unroll
                for (int r = 0; r < 4; ++r) if (16 * ms + 4 * g + r > 16 * nt + c) at[ms][nt][r] = 0.f;
        const LAS unsigned char* vp = lds + T_V + (4 * g + (c >> 2)) * PT + (d0 + 4 * (c & 3)) * 2;
        const bf16x8 vf = cat(tr16(vp), tr16(vp + 16 * PT));
#pragma unroll
        for (int mt = 0; mt < 2; ++mt) o[mt] = __builtin_amdgcn_mfma_f32_16x16x32_bf16(pack8f(at[0][mt], at[1][mt]), vf, o[mt], 0, 0, 0);
#pragma unroll
        for (int m = 0; m < 8; ++m) {
            const f32x4 dc = *(const LAS f32x4*)(lds + O_DEC + (16 * m + 4 * g) * 4);
            const LAS unsigned char* kp = lds + T_KD + (4 * g + (c >> 2)) * PT + (16 * m + 4 * (c & 3)) * 2;
            S[m] = __builtin_amdgcn_mfma_f32_16x16x32_bf16(cat(tr16(kp), tr16(kp + 16 * PT)), vf, S[m] * dc, 0, 0, 0);
        }
#pragma unroll
        for (int mt = 0; mt < 2; ++mt)
#pragma unroll
            for (int r = 0; r < 4; ++r) { const float q2 = row16_sum(o[mt][r] * o[mt][r]);
                if (c == 0) *(LAS float*)(lds + O_SSQ + ((16 * mt + 4 * g + r) * 8 + wave) * 4) = q2; }
        WG_BAR();
        if (ch < 7) p2_prepare(ldn, d0, lane);
#pragma unroll
        for (int mt = 0; mt < 2; ++mt)
#pragma unroll
            for (int r = 0; r < 4; ++r) { const int t = 16 * mt + 4 * g + r;
                const f32x4 p0 = *(const LAS f32x4*)(lds + O_SSQ + t * 32), p1 = *(const LAS f32x4*)(lds + O_SSQ + t * 32 + 16);
                const float tot = ((p0[0] + p0[1]) + (p0[2] + p0[3])) + ((p1[0] + p1[1]) + (p1[2] + p1[3]));
                const float rstd = __builtin_amdgcn_rsqf(tot * (1.0f / 128.0f) + EPS);
                const float gate = ldsbf(lds + T_G + t * PQ + (d0 + c) * 2);
                stsbf(lds + T_KR + t * PQ + (d0 + c) * 2, o[mt][r] * rstd * gn * gate); }
        WG_BAR();
        *(v4u*)(MIXB + (row0 + ch * 32 + srow) * D + 512 + h * 128 + sc16 * 8) = *(const LAS v4u*)(lds + T_KR + srow * PQ + sc16 * 16);
    }
#undef P2_WRITE_RAW
#undef P2_LOAD_RAW
}

__device__ __forceinline__ void sample_load(const bf16* PROJ, const float* st_in, const int it, const int tid, f32x4 (&S)[8], v4u (&lw)[DS], v4u (&qw)[DS], u32x2 (&vw)[DS]) {
    const int dvq = tid & 31, rgp = tid >> 5, sb = it >> 2, h = it & 3;
    const size_t so = ((size_t)(sb * 4 + h) * 128 + rgp * 8) * 128 + 4 * dvq;
#pragma unroll
    for (int r = 0; r < 8; ++r) S[r] = *(const f32x4*)(st_in + so + (size_t)r * 128);
#pragma unroll
    for (int t = 0; t < DS; ++t) { const bf16* rp = PROJ + (size_t)(NTP + sb * 4 + t) * INW + h * 128;
        lw[t] = *(const v4u*)(rp + C_FH + rgp * 8); qw[t] = *(const v4u*)(rp + C_QH + rgp * 8); vw[t] = *(const u32x2*)(rp + C_IH + 4 * dvq); }
}
__device__ __forceinline__ void sample_compute(LAS unsigned char* lds, const bf16* PROJ, float* st_out, const float* onorm, bf16* MIXB, const int it, const int tid,
                                               f32x4 (&S)[8], const v4u (&lw)[DS], const v4u (&qw)[DS], const u32x2 (&vw)[DS]) {
    const int lane = tid & 63, wave = __builtin_amdgcn_readfirstlane(tid >> 6), dvq = tid & 31, rgp = tid >> 5;
    const int sb = it >> 2, h = it & 3;
    const size_t so = ((size_t)(sb * 4 + h) * 128 + rgp * 8) * 128 + 4 * dvq;
    LAS float* red = (LAS float*)lds; LAS float* osh = red + 16 * 128;
#pragma unroll
    for (int t = 0; t < DS; ++t) {
        const f32x4 v4 = (f32x4){__builtin_bit_cast(float, vw[t].x << 16), __builtin_bit_cast(float, vw[t].x & 0xffff0000u), __builtin_bit_cast(float, vw[t].y << 16), __builtin_bit_cast(float, vw[t].y & 0xffff0000u)};
        f32x4 po = (f32x4){0.f, 0.f, 0.f, 0.f};
#pragma unroll
        for (int r = 0; r < 8; ++r) { const unsigned lwd = lw[t][r >> 1], qwd = qw[t][r >> 1];
            const float lf = __builtin_bit_cast(float, (r & 1) ? (lwd & 0xffff0000u) : (lwd << 16)), q = __builtin_bit_cast(float, (r & 1) ? (qwd & 0xffff0000u) : (qwd << 16));
            const float f = __builtin_amdgcn_exp2f(lf), k = 1.0f - f;
            S[r] = S[r] * f + v4 * k; po += S[r] * q; }
        *(LAS f32x4*)(red + (t * 16 + rgp) * 128 + 4 * dvq) = po;
    }
#pragma unroll
    for (int r = 0; r < 8; ++r) *(f32x4*)(st_out + so + (size_t)r * 128) = S[r];
    WG_BAR();
    { const int t = tid >> 7, e = tid & 127; float a = 0.f;
#pragma unroll
      for (int j = 0; j < 16; ++j) a += red[(t * 16 + j) * 128 + e];
      osh[t * 128 + e] = a; }
    WG_BAR();
    if (wave < DS) { const int t = wave; const float a = osh[t * 128 + lane], b2 = osh[t * 128 + 64 + lane];
        const float rstd = __builtin_amdgcn_rsqf(wave_sum(a * a + b2 * b2) * (1.0f / 128.0f) + EPS);
        const size_t m = (size_t)NTP + sb * 4 + t; const bf16* gp = PROJ + m * INW + C_GH + h * 128;
        MIXB[m * D + 512 + h * 128 + lane] = (bf16)pkb1(a * rstd * onorm[lane] * bf2f(gp[lane]));
        MIXB[m * D + 512 + h * 128 + 64 + lane] = (bf16)pkb1(b2 * rstd * onorm[64 + lane] * bf2f(gp[64 + lane])); }
    WG_BAR();
}
}

namespace sg {
typedef short bf16x8 __attribute__((ext_vector_type(8)));
typedef unsigned u32x2 __attribute__((ext_vector_type(2)));
constexpr int CP = 1040, A_OFF = 0, B_OFF = 32 * CP, RED_OFF = B_OFF;
__device__ __forceinline__ void load_chunk(v4u (&r)[12], const bf16* A, const bf16* Bt, const int K, const int ntn, const int it, const int ch, const int tid) {
    const int tm = it / ntn, tn = it % ntn, row = tid >> 6, c16 = tid & 63;
    const bf16* ap = A + (size_t)(tm * 32 + row) * K + ch * 512 + c16 * 8;
    const bf16* bp = Bt + (size_t)(tn * 64 + row) * K + ch * 512 + c16 * 8;
#pragma unroll
    for (int i = 0; i < 4; ++i) r[i] = *(const v4u*)(ap + (size_t)(8 * i) * K);
#pragma unroll
    for (int i = 0; i < 8; ++i) r[4 + i] = *(const v4u*)(bp + (size_t)(8 * i) * K);
}
__device__ __forceinline__ void store_chunk(LAS unsigned char* lds, const v4u (&r)[12], const int tid) {
    const int row = tid >> 6, c16 = tid & 63;
#pragma unroll
    for (int i = 0; i < 4; ++i) *(LAS v4u*)(lds + A_OFF + (row + 8 * i) * CP + c16 * 16) = r[i];
#pragma unroll
    for (int i = 0; i < 8; ++i) *(LAS v4u*)(lds + B_OFF + (row + 8 * i) * CP + c16 * 16) = r[4 + i];
}
struct FinalArgs { float* out; const float* gain; float* slots; unsigned* cnt; unsigned* tmo; };
__device__ __forceinline__ void finish_tile(LAS unsigned char* lds, f32x4 (&acc)[2][2], const int ntn, const int it, const int kind, bf16* xb, float* ssq_w, const float pre_ssq, bf16* U,
                                            const int tid, const int c, const int g, const int sub, const int kq, const FinalArgs& fa, const bool scaled) {
    const int tm = it / ntn, tn = it % ntn;
    LAS float* red = (LAS float*)(lds + RED_OFF);
#pragma unroll
    for (int i = 0; i < 2; ++i)
#pragma unroll
        for (int j = 0; j < 2; ++j)
#pragma unroll
            for (int r = 0; r < 4; ++r) { red[(kq * 32 + 16 * i + 4 * g + r) * 64 + sub * 32 + 16 * j + c] = acc[i][j][r]; acc[i][j][r] = 0.f; }
    WG_BAR();
    const int row = tid >> 4, cq = tid & 15;
    f32x4 v = *(const LAS f32x4*)(red + row * 64 + 4 * cq);
#pragma unroll
    for (int q = 1; q < 4; ++q) v += *(const LAS f32x4*)(red + (q * 32 + row) * 64 + 4 * cq);
    const size_t grow = (size_t)NTP + tm * 32 + row; const int gcol = tn * 64 + 4 * cq;
    {
        if (scaled) {
            float p = pre_ssq;
            p += __shfl_xor(p, 1); p += __shfl_xor(p, 2); p += __shfl_xor(p, 4); p += __shfl_xor(p, 8);
            v *= __builtin_amdgcn_rcpf(p * (1.0f / 1024.0f) + EPS);
        }
        const u32x2 xo = *(const u32x2*)(xb + grow * D + gcol);
        const f32x4 x = (f32x4){__builtin_bit_cast(float, xo.x << 16), __builtin_bit_cast(float, xo.x & 0xffff0000u), __builtin_bit_cast(float, xo.y << 16), __builtin_bit_cast(float, xo.y & 0xffff0000u)} + v;
        float ss = (x[0] * x[0] + x[1] * x[1]) + (x[2] * x[2] + x[3] * x[3]);
        ss += __shfl_xor(ss, 1); ss += __shfl_xor(ss, 2); ss += __shfl_xor(ss, 4); ss += __shfl_xor(ss, 8);
        if (kind != 4) {
            u32x2 w; w.x = pkb(x[0], x[1]); w.y = pkb(x[2], x[3]); *(u32x2*)(xb + grow * D + gcol) = w;
            if (cq == 0) ssq_w[grow * 16 + tn] = ss;
        } else {
            float* sl = fa.slots + ((size_t)tm * 32 + row) * 16;
            if (cq == 0) __hip_atomic_store(sl + tn, ss, __ATOMIC_RELAXED, __HIP_MEMORY_SCOPE_AGENT);
            asm volatile("s_waitcnt vmcnt(0)" ::: "memory");
            WG_BAR();
            const int wave = __builtin_amdgcn_readfirstlane(tid >> 6);
            if (wave == 0) {
                if ((tid & 63) == 0) __hip_atomic_fetch_add(fa.cnt + 64 * tm, 1u, __ATOMIC_RELAXED, __HIP_MEMORY_SCOPE_AGENT);
                unsigned spins = 0;
                while ((unsigned)__builtin_amdgcn_readfirstlane(__hip_atomic_load(fa.cnt + 64 * tm, __ATOMIC_RELAXED, __HIP_MEMORY_SCOPE_AGENT)) < (unsigned)ntn) {
                    if (++spins > (1u << 20)) { if ((tid & 63) == 0) __hip_atomic_store(fa.tmo, 1u, __ATOMIC_RELAXED, __HIP_MEMORY_SCOPE_AGENT); break; }
                    __builtin_amdgcn_s_sleep(2); }
                __builtin_amdgcn_fence(__ATOMIC_ACQUIRE, "agent");
                asm volatile("s_waitcnt vmcnt(0)" ::: "memory");
            }
            WG_BAR();
            float t = __hip_atomic_load(sl + cq, __ATOMIC_RELAXED, __HIP_MEMORY_SCOPE_AGENT);
            t += __shfl_xor(t, 1); t += __shfl_xor(t, 2); t += __shfl_xor(t, 4); t += __shfl_xor(t, 8);
            const float rstd = __builtin_amdgcn_rsqf(t * (1.0f / 1024.0f) + EPS);
            *(f32x4*)(fa.out + grow * D + gcol) = x * rstd * *(const f32x4*)(fa.gain + gcol);
        }
    }
    WG_BAR();
}
__device__ __forceinline__ void stream(LAS unsigned char* lds, const bf16* A, const bf16* Bt, const int K, const int ntn, const int first0, const int stride, const int nit, const int j0, const int j1, const int kind,
                                       bf16* xb, float* ssq_w, const float* ssq_r, bf16* U, const int tid, const FinalArgs& fa, const bool scaled) {
    const int lane = tid & 63, wave = __builtin_amdgcn_readfirstlane(tid >> 6), c = lane & 15, g = lane >> 4, sub = wave & 1, kq = wave >> 1;
    if (first0 >= nit) return;
    const int nch = K >> 9;
    const int nall = (nit - first0 + stride - 1) / stride;
    const int je = j1 < nall ? j1 : nall; if (j0 >= je) return;
    const int first = first0 + j0 * stride, Q = (je - j0) * nch;
    f32x4 acc[2][2];
#pragma unroll
    for (int i = 0; i < 2; ++i)
#pragma unroll
        for (int j = 0; j < 2; ++j) acc[i][j] = (f32x4){0.f, 0.f, 0.f, 0.f};
    v4u r[12];
    load_chunk(r, A, Bt, K, ntn, first, 0, tid);
    float pre = 0.f;
    const LAS unsigned char* ard = lds + A_OFF + c * CP + (kq * 128 + 8 * g) * 2;
    const LAS unsigned char* brd = lds + B_OFF + (sub * 32 + c) * CP + (kq * 128 + 8 * g) * 2;
    for (int q = 0; q < Q; ++q) {
        const int ti = q / nch, ch = q % nch, it = first + ti * stride;
        store_chunk(lds, r, tid);
        if (ch == 0 && scaled) pre = ssq_r[((size_t)NTP + (it / ntn) * 32 + (tid >> 4)) * 16 + (tid & 15)];
        WG_BAR();
        if (q + 1 < Q) { const int t1 = (q + 1) / nch; load_chunk(r, A, Bt, K, ntn, first + t1 * stride, (q + 1) % nch, tid); }
#pragma unroll
        for (int u = 0; u < 4; ++u) {
            const bf16x8 a0 = *(const LAS bf16x8*)(ard + 64 * u), a1 = *(const LAS bf16x8*)(ard + 16 * CP + 64 * u), b0 = *(const LAS bf16x8*)(brd + 64 * u), b1 = *(const LAS bf16x8*)(brd + 16 * CP + 64 * u);
            acc[0][0] = __builtin_amdgcn_mfma_f32_16x16x32_bf16(a0, b0, acc[0][0], 0, 0, 0); acc[0][1] = __builtin_amdgcn_mfma_f32_16x16x32_bf16(a0, b1, acc[0][1], 0, 0, 0);
            acc[1][0] = __builtin_amdgcn_mfma_f32_16x16x32_bf16(a1, b0, acc[1][0], 0, 0, 0); acc[1][1] = __builtin_amdgcn_mfma_f32_16x16x32_bf16(a1, b1, acc[1][1], 0, 0, 0);
        }
        WG_BAR();
        if (ch == nch - 1) finish_tile(lds, acc, ntn, it, kind, xb, ssq_w, pre, U, tid, c, g, sub, kq, fa, scaled);
    }
}
constexpr int UP_P = 528, UP_A = 0, UP_B = 128 * UP_P, UP_SP = 68;
__device__ __forceinline__ void up_load(v4u (&r)[12], const bf16* A, const bf16* Bt, const int tm, const int tn, const int ch, const int tid) {
    const int row = tid >> 5, seg = tid & 31;
    const bf16* ap = A + (size_t)(tm * 128 + row) * D + ch * 256 + seg * 8;
    const bf16* bp = Bt + (size_t)(tn * 64 + row) * D + ch * 256 + seg * 8;
#pragma unroll
    for (int i = 0; i < 8; ++i) r[i] = *(const v4u*)(ap + (size_t)(16 * i) * D);
#pragma unroll
    for (int i = 0; i < 4; ++i) r[8 + i] = *(const v4u*)(bp + (size_t)(16 * i) * D);
}
__device__ __forceinline__ void up_store(LAS unsigned char* lds, const v4u (&r)[12], const int tid) {
    const int row = tid >> 5, seg = tid & 31;
#pragma unroll
    for (int i = 0; i < 8; ++i) *(LAS v4u*)(lds + UP_A + (row + 16 * i) * UP_P + seg * 16) = r[i];
#pragma unroll
    for (int i = 0; i < 4; ++i) *(LAS v4u*)(lds + UP_B + (row + 16 * i) * UP_P + seg * 16) = r[8 + i];
}
__device__ __forceinline__ void up_tile(LAS unsigned char* lds, const bf16* A, const bf16* Bt, const float* ssq_r, bf16* U, const int it, const int tid) {
    const int lane = tid & 63, wave = __builtin_amdgcn_readfirstlane(tid >> 6), c = lane & 15, g = lane >> 4, sub = wave & 1, rg = wave >> 1;
    const int tm = it >> 6, tn = it & 63;
    const int orow = tid >> 2, oq = tid & 3;
    const size_t grow = (size_t)NTP + tm * 128 + orow;
    f32x4 acc[2][2];
#pragma unroll
    for (int i = 0; i < 2; ++i)
#pragma unroll
        for (int j = 0; j < 2; ++j) acc[i][j] = (f32x4){0.f, 0.f, 0.f, 0.f};
    v4u r[12];
    up_load(r, A, Bt, tm, tn, 0, tid);
    const LAS unsigned char* ard = lds + UP_A + (32 * rg + c) * UP_P + 16 * g;
    const LAS unsigned char* brd = lds + UP_B + (32 * sub + c) * UP_P + 16 * g;
    for (int ch = 0; ch < 4; ++ch) {
        up_store(lds, r, tid);
        WG_BAR();
        if (ch < 3) up_load(r, A, Bt, tm, tn, ch + 1, tid);
#pragma unroll
        for (int u = 0; u < 8; ++u) {
            const bf16x8 a0 = *(const LAS bf16x8*)(ard + 64 * u), a1 = *(const LAS bf16x8*)(ard + 16 * UP_P + 64 * u), b0 = *(const LAS bf16x8*)(brd + 64 * u), b1 = *(const LAS bf16x8*)(brd + 16 * UP_P + 64 * u);
            acc[0][0] = __builtin_amdgcn_mfma_f32_16x16x32_bf16(a0, b0, acc[0][0], 0, 0, 0); acc[0][1] = __builtin_amdgcn_mfma_f32_16x16x32_bf16(a0, b1, acc[0][1], 0, 0, 0);
            acc[1][0] = __builtin_amdgcn_mfma_f32_16x16x32_bf16(a1, b0, acc[1][0], 0, 0, 0); acc[1][1] = __builtin_amdgcn_mfma_f32_16x16x32_bf16(a1, b1, acc[1][1], 0, 0, 0);
        }
        WG_BAR();
    }
    LAS float* S = (LAS float*)lds;
#pragma unroll
    for (int i = 0; i < 2; ++i)
#pragma unroll
        for (int j = 0; j < 2; ++j)
#pragma unroll
            for (int q = 0; q < 4; ++q) { const float a = fmaxf(acc[i][j][q], 0.f); S[(32 * rg + 16 * i + 4 * g + q) * UP_SP + 32 * sub + 16 * j + c] = a * a; }
    WG_BAR();
    const LAS float* sp = S + orow * UP_SP + 16 * oq;
    const f32x4 s0 = *(const LAS f32x4*)sp, s1 = *(const LAS f32x4*)(sp + 4), s2 = *(const LAS f32x4*)(sp + 8), s3 = *(const LAS f32x4*)(sp + 12);
    v4u w0, w1;
    w0.x = pkb(s0[0], s0[1]); w0.y = pkb(s0[2], s0[3]); w0.z = pkb(s1[0], s1[1]); w0.w = pkb(s1[2], s1[3]);
    w1.x = pkb(s2[0], s2[1]); w1.y = pkb(s2[2], s2[3]); w1.z = pkb(s3[0], s3[1]); w1.w = pkb(s3[2], s3[3]);
    bf16* up = U + grow * FF + tn * 64 + 16 * oq;
    *(v4u*)up = w0; *(v4u*)(up + 8) = w1;
    WG_BAR();
}
}

__global__ void __launch_bounds__(NWAVES * 64, 2) mk_fwd(Args args) {
    extern __shared__ __attribute__((aligned(16))) unsigned char lds_raw[];
    LAS unsigned char* lds = (LAS unsigned char*)lds_raw;
    volatile LAS unsigned* MISC = (volatile LAS unsigned*)(lds + MISC_OFF);
    const int tid0 = threadIdx.x, wave = __builtin_amdgcn_readfirstlane(tid0 >> 6);
#define FRESH_TID(name) int name; asm volatile("v_mbcnt_lo_u32_b32 %0, -1, 0\n\tv_mbcnt_hi_u32_b32 %0, -1, %0\n\tv_lshl_or_b32 %0, %1, 6, %0" : "=&v"(name) : "s"(wave))
    const int G = gridDim.x; const int bx = blockIdx.x; const int vcu = (G % 8 == 0) ? (bx % 8) * (G / 8) + bx / 8 : bx;
    unsigned char* ws = args.ws;
    gu32* ctl = (gu32*)(ws + WS_CTL);
    for (int u = tid0; u < (LDS_BYTES - LDSCTL_OFF) / 4; u += NWAVES * 64) ((LAS unsigned*)(lds + LDSCTL_OFF))[u] = 0u;
    __syncthreads();
    const int lo = args.ph_lo, hi = args.ph_hi;
    XcdBarrier bar; bar.bar = (unsigned*)(ctl + CW_BAR); bar.x = 0; bar.st = nullptr;
    bar = xcd_barrier_post((unsigned*)(ctl + CW_BAR), MISC + 8);
    XcdBarrier barS = xcd_barrier_post((unsigned*)(ctl + CW_BAR) + XCD_BAR_WORDS, MISC + 12);
#define IN(k) (lo <= (k) && (k) < hi)
#define SEAM(k) do { if (IN(k) && IN((k) + 1)) xcd_barrier(bar); } while (0)

    if (IN(0)) { FRESH_TID(tid_q); phase_prologue(args, lds, vcu, G, wave, tid_q & 63, tid_q); if (IN(1)) xcd_arrive(bar); }

    for (int ph = (lo > 1 ? lo : 1); ph < (hi < 15 ? hi : 15); ++ph) {
        const int l = (ph - 1) / 7, k = (ph - 1) % 7;
        if (k == 1) {
            FRESH_TID(tid_a);
            const bf16* PRJ = (const bf16*)(ws + WS_PROJ); bf16* MX = (bf16*)(ws + WS_MIX); bf16* MXS = (bf16*)(ws + WS_MIXS) - (size_t)NTP * D;
            const float* st_in = args.in[4] + (size_t)l * 8388608; float* st_out = args.out + OFF_NSS + (size_t)l * 8388608; const float* onorm = args.in[9] + l * 128;
            for (int it = vcu; it < 256; it += G) hg::pass1_item(lds + RING_OFF, PRJ, (float*)(ws + WS_HG), (float*)(ws + WS_HG + 16 * MiB), it, tid_a);
            xcd_arrive(bar);
            const int mgrp = vcu & 1;
#pragma nounroll
            for (int stage = 0; stage < 2; ++stage) {
                if ((stage ^ mgrp) == 0) { FRESH_TID(tid_b);
                    att::run<5>(lds + RING_OFF, PRJ, args.in[2] + (size_t)l * 2097152, args.in[3] + (size_t)l * 2097152, args.in[7] + l * 8, MX, MXS, vcu, G, 768, tid_b);
                } else { FRESH_TID(tid_s);
                    f32x4 SA[8], SB[8]; v4u lwA[DS], qwA[DS], lwB[DS], qwB[DS]; hg::u32x2 vwA[DS], vwB[DS];
                    for (int sa = vcu; sa < 512; sa += 2 * G) {
                        const int sb2 = sa + G;
                        hg::sample_load(PRJ, st_in, sa, tid_s, SA, lwA, qwA, vwA);
                        hg::sample_load(PRJ, st_in, sb2 < 512 ? sb2 : 511, tid_s, SB, lwB, qwB, vwB);
                        hg::sample_compute(lds + RING_OFF, PRJ, st_out, onorm, MXS, sa, tid_s, SA, lwA, qwA, vwA);
                        if (sb2 < 512) hg::sample_compute(lds + RING_OFF, PRJ, st_out, onorm, MXS, sb2, tid_s, SB, lwB, qwB, vwB);
                    } }
                if (stage == 0) {
                    xcd_wait(bar);
                    { FRESH_TID(tid_c);
                      hg::combine_phase((float*)(ws + WS_HG), (const float*)(ws + WS_HG + 16 * MiB), args.out + OFF_NSP + (size_t)l * 262144, vcu * (NWAVES * 64) + tid_c, G * NWAVES * 64); }
                    xcd_arrive(bar);
                }
            }
            xcd_wait(bar);
            { FRESH_TID(tid_p);
              for (int it = vcu; it < 256; it += G) hg::pass2_item(lds + RING_OFF, PRJ, (const float*)(ws + WS_HG), onorm, MX, it, tid_p); }
            if (IN(ph + 2) && IN(ph + 3)) { xcd_arrive(bar);
                { FRESH_TID(tid_cc);
                  convert_weights(args, lds, vcu * NWAVES + wave, G * NWAVES, l * PER_L + I_IN + I_O + I_UP, (l + 1) * PER_L, 0, (I_DN + G * NWAVES - 1) / (G * NWAVES), wave, tid_cc & 63);
                  if (G != 256) { const int citer = (DEPTH * DB * 2 * 3968 + 8 * G * NWAVES * 64 - 1) / (8 * G * NWAVES * 64), chalf = (citer + 1) / 2;
                      copy_caches(args, vcu * (NWAVES * 64) + tid_cc, G * NWAVES * 64, l * chalf, (l + 1) * chalf); } }
                xcd_wait(bar); }
            continue;
        }
        if (k == 2 || k == 3) continue;
        bf16* XB = (bf16*)(ws + WS_XB); bf16* PROJ = (bf16*)(ws + WS_PROJ); bf16* MIXB = (bf16*)(ws + WS_MIX); bf16* UB = (bf16*)(ws + WS_U);
        pg8::Gemm g; pg8::EpiAny E{0, l, ws, args.out, args.in[0], args.in[1], WS_ROT, WS_LB, WS_SSQ, SSQ_STRIDE, WS_PROJ, WS_XB, WS_U, OFF_NKP, OFF_NVP, OFF_NKS, OFF_NVS, args.in[14], WS_FSL, CW_FNP, lds + FIN_OFF};
        const bool fin = (k == 6 && l + 1 == DEPTH);
        if (k == 0)      { g = pg8::Gemm{XB, (const bf16*)(ws + WS_WIN) + (size_t)l * INW * D, M, INW, D}; E.kind = 0; }
        else if (k == 4) { g = pg8::Gemm{MIXB, (const bf16*)(ws + WS_WO) + (size_t)l * D * D, NTP, D, D}; E.kind = 2; }
        else if (k == 5) { g = pg8::Gemm{XB, (const bf16*)(ws + WS_WUP) + (size_t)l * FF * D, NTP, FF, D}; E.kind = 1; }
        else             { g = pg8::Gemm{UB, (const bf16*)(ws + WS_WDN) + (size_t)l * D * FF, NTP, D, FF}; E.kind = fin ? 5 : 3; }
        pg8::StaticOrder S; S.init(g.M, g.N, G, bx);
        FRESH_TID(tid_o);
        const int ntn = g.N >> 6, nit = 16 * ntn, npre = (k >= 4 && !fin) ? (vcu & 1) : 0;
        const int xcd_s = vcu >> 5, loc_s = vcu & 31;
        const int sit = (G == 256) ? ((xcd_s >> 2) * 8 + (loc_s >> 2)) * 16 + (xcd_s & 3) * 4 + (loc_s & 3) : vcu;
        const int uit = (G == 256) ? (loc_s >> 3) * 64 + xcd_s * 8 + (loc_s & 7) : vcu;
        const sg::FinalArgs fa{args.out, args.in[14], (float*)(ws + WS_FSLS), (unsigned*)ws + CW_FNS, (unsigned*)ws};
        float* ssq_w = (float*)(ws + WS_SSQ + (size_t)(2 * l + (k == 4 ? 1 : 2)) * SSQ_STRIDE);
        const float* ssq_r = (const float*)(ws + WS_SSQ + (size_t)(2 * l + 1) * SSQ_STRIDE);
        const int NGWf = G * NWAVES, f_lo = (l == 0) ? I_IN : PER_L + I_IN, f_hi = (l == 0) ? PER_L + I_IN : 2 * PER_L - I_DN, f_hole = (l == 0) ? PER_L - I_DN : (1 << 30), f_hlen = (l == 0) ? I_DN : 0;
        const int f_n = (f_hi - f_lo - f_hlen + NGWf - 1) / NGWf, fgrp = vcu % 3;
        const int f_pre = (f_n * fgrp + 1) / 2, c_pre = 0, c_n = 0;
        const bool lightcu = (G == 256) && (bx >= 214);
        if (k == 0) { const int lane_o = tid_o & 63;
            convert_weights(args, lds, vcu * NWAVES + wave, NGWf, f_lo, f_hi, 0, f_pre, wave, lane_o, f_hole, f_hlen);
            copy_caches(args, vcu * (NWAVES * 64) + tid_o, G * NWAVES * 64, 0, c_pre);
            if (IN(ph - 1)) { xcd_wait(bar); if (l > 0) xcd_wait(barS); } else __syncthreads(); }
        if (k >= 4 && npre > 0) { FRESH_TID(tid_s);
            if (k > 4) xcd_wait(barS);
            if (k == 5) { for (int it = uit; it < 256; it += G) sg::up_tile(lds + RING_OFF, XB + (size_t)NTP * D, g.Bt, ssq_r, UB, it, tid_s); }
            else sg::stream(lds + RING_OFF, k == 4 ? (const bf16*)(ws + WS_MIXS) : g.A + (size_t)NTP * g.K, g.Bt, g.K, ntn, sit, G, nit, 0, npre, 2, XB, ssq_w, ssq_r, UB, tid_s, fa, k == 6); }
        if (k > 4) xcd_wait(bar);
        pg8::gemm_phase<pg8::EpiAny, pg8::StaticOrder, true, true>(lds + RING_OFF, g, S, E, tid_o);
        if (k == 0) {
            FRESH_TID(tid_f); const int lane_f = tid_f & 63;
            if (IN(ph + 1)) xcd_arrive(bar);
            convert_weights(args, lds, vcu * NWAVES + wave, NGWf, f_lo, f_hi, f_pre, f_n, wave, lane_f, f_hole, f_hlen);
            if (lightcu) copy_caches(args, (bx - 214) * (NWAVES * 64) + tid_f, 42 * NWAVES * 64, 6 * l, 6 * l + 6);
            copy_caches(args, vcu * (NWAVES * 64) + tid_f, G * NWAVES * 64, c_pre, c_n);
            if (IN(ph + 1)) xcd_wait(bar);
            continue;
        }
        if (!fin) xcd_arrive(bar);
        { FRESH_TID(tid_s);
            if (k > 4 && npre == 0) xcd_wait(barS);
            if (k == 5) { if (npre == 0) for (int it = uit; it < 256; it += G) sg::up_tile(lds + RING_OFF, XB + (size_t)NTP * D, g.Bt, ssq_r, UB, it, tid_s); }
            else sg::stream(lds + RING_OFF, k == 4 ? (const bf16*)(ws + WS_MIXS) : g.A + (size_t)NTP * g.K, g.Bt, g.K, ntn, sit, G, nit, npre, 1 << 20, fin ? 4 : 2, XB, ssq_w, ssq_r, UB, tid_s, fa, k == 6);
            if (!fin) xcd_arrive(barS); }
    }
    if (IN(15) && !IN(14)) { FRESH_TID(tid_n); phase_final_norm(args, vcu, G, wave, tid_n & 63); }
#undef IN
#undef SEAM
}

extern "C" void kernel_launch(void* const* d_in, const int* in_sizes, int n_in, void* d_out, int out_size, void* d_ws, size_t ws_size, hipStream_t stream) {
    static int grid = 0;
    if (grid == 0) {
        if (n_in != 15 || in_sizes[0] != NTP * D || (size_t)out_size != OUT_TOTAL || ws_size < WS_END) {
            fprintf(stderr, "kernel_launch: unexpected shapes (n_in %d, in0 %d, out %d, ws %zu)\n", n_in, n_in > 0 ? in_sizes[0] : -1, out_size, ws_size); grid = -1; return; }
        int dev = 0, cus = 0, per_cu = 0;
        if (hipGetDevice(&dev) != hipSuccess || hipDeviceGetAttribute(&cus, hipDeviceAttributeMultiprocessorCount, dev) != hipSuccess) { grid = -1; return; }
        if (hipFuncSetAttribute((const void*)mk_fwd, hipFuncAttributeMaxDynamicSharedMemorySize, LDS_BYTES) != hipSuccess) { fprintf(stderr, "kernel_launch: hipFuncSetAttribute failed\n"); grid = -1; return; }
        if (hipOccupancyMaxActiveBlocksPerMultiprocessor(&per_cu, (const void*)mk_fwd, NWAVES * 64, LDS_BYTES) != hipSuccess || per_cu < 1) { fprintf(stderr, "kernel_launch: occupancy query says %d\n", per_cu); }
        (void)hipGetLastError();
        grid = cus;
    }
    if (grid < 0) return;
    (void)hipMemsetAsync((char*)d_ws + WS_CTL, 0, CTL_ZERO_BYTES, stream);
    Args a{};
    for (int i = 0; i < 15; ++i) a.in[i] = (const float*)d_in[i];
    a.out = (float*)d_out; a.ws = (unsigned char*)d_ws;
    for (int j = 0; j < 8; ++j) a.invf[j] = pow(500000.0, -(double)j / 8.0);
    auto run = [&](int lo, int hi) { a.ph_lo = lo; a.ph_hi = hi; hipLaunchKernelGGL(mk_fwd, dim3(grid), dim3(NWAVES * 64), LDS_BYTES, stream, a); };
#ifdef PROBE_PREFIX
    run(0, PROBE_PREFIX);
    (void)hipMemsetAsync((char*)d_ws + WS_CTL, 0, CTL_ZERO_BYTES, stream);
#endif
    run(0, 16);
}
```
